# Optimizing an MI355X kernel written in HIP

```python
import jax
import jax.numpy as jnp
from jax import lax
import numpy as np

D_MODEL = 1024
BATCH = 1
SEQ = 16384
DEPTH = 4

GRID_W = 64
CTX_LEN = 256
N_MIXERS = 2
N_MOD = 6
DN_ALPHA = (2.0 * DEPTH) ** 0.25
DN_BETA = (8.0 * DEPTH) ** -0.25
LN_EPS = 1e-5

MLSTM_HEADS = 4
MLSTM_DH = D_MODEL // MLSTM_HEADS
MLSTM_CHUNK = 128
MLSTM_PROJ = 4 * D_MODEL + 4 * MLSTM_HEADS
CONV_K = 3
M_INIT = -1e30

RWKV_N = 64
RWKV_HEADS = D_MODEL // RWKV_N
DECAY_LORA = 64
AAA_LORA = 64
GATE_LORA = 160
RWKV_GN_EPS = 64e-5

N_KEYS = 128
N_EXPERTS = N_KEYS * N_KEYS
PEER_HEADS = 8
PEER_DQ = 256
PEER_TOPK = 16
PEER_BLOCK = 128

N_MLSTM_LAYERS = (DEPTH + 1) // 2
N_RWKV_LAYERS = DEPTH // 2

kernel_name = "hybrid_mlstm_rwkv7_peer_flow_block"


def _layernorm(x, g, b):
    xf = x.astype(jnp.float32)
    mu = jnp.mean(xf, -1, keepdims=True)
    var = jnp.mean(jnp.square(xf - mu), -1, keepdims=True)
    return ((xf - mu) * lax.rsqrt(var + LN_EPS)).astype(x.dtype) * g + b


def _head_norm(h, eps):
    hf = h.astype(jnp.float32)
    mu = jnp.mean(hf, -1, keepdims=True)
    var = jnp.mean(jnp.square(hf - mu), -1, keepdims=True)
    return (hf - mu) * lax.rsqrt(var + eps)


def _grid_dwconv(u, w, b, rows):
    bsz, n, ch = u.shape
    img = u.reshape(bsz, rows, GRID_W, ch)
    out = lax.conv_general_dilated(img, w[:, :, None, :].astype(u.dtype), (1, 1), "SAME",
                                   dimension_numbers=("NHWC", "HWIO", "NHWC"),
                                   feature_group_count=ch)
    return out.reshape(bsz, n, ch) + b


def _seq_dwconv(u, w, b):
    p = jnp.pad(u, ((0, 0), (1, 1), (0, 0)))
    wc = w[CONV_K // 2]
    return p[:, :-2] * wc[0] + p[:, 1:-1] * wc[1] + p[:, 2:] * wc[2] + b


def _qshift_grid(u, rows):
    bsz, n, d = u.shape
    q = d // 4
    p = jnp.pad(u.reshape(bsz, rows, GRID_W, d), ((0, 0), (1, 1), (1, 1), (0, 0)))
    out = jnp.concatenate([p[:, 1:-1, :-2, :q], p[:, 1:-1, 2:, q:2 * q],
                           p[:, :-2, 1:-1, 2 * q:3 * q], p[:, 2:, 1:-1, 3 * q:]], axis=-1)
    return out.reshape(bsz, n, d)


def _shift_seq(u):
    h = u.shape[-1] // 2
    p = jnp.pad(u, ((0, 0), (1, 1), (0, 0)))
    return jnp.concatenate([p[:, :-2, :h], p[:, 2:, h:]], axis=-1)


def _mlstm_scan(q, k, v, ig, lf, state):
    bsz, nh, t, dh = q.shape
    nc = t // MLSTM_CHUNK

    def to_chunks(a):
        return jnp.moveaxis(a.reshape(bsz, nh, nc, MLSTM_CHUNK, *a.shape[3:]), 2, 0)

    causal = jnp.tril(jnp.ones((MLSTM_CHUNK, MLSTM_CHUNK), bool))

    def step(carry, inp):
        c_st, n_st, m_st = carry
        qc, kc, vc, ic, fc = inp
        b = jnp.cumsum(fc, axis=-1)
        dlog = b[..., :, None] - b[..., None, :] + ic[..., None, :]
        dlog = jnp.where(causal, dlog, -jnp.inf)
        m_inter = b + m_st[..., None]
        m_t = jnp.maximum(m_inter, jnp.max(dlog, axis=-1))
        s = jnp.einsum('bhtd,bhsd->bhts', qc, kc) * jnp.exp(dlog - m_t[..., None])
        dec = jnp.exp(m_inter - m_t)
        num = jnp.einsum('bhts,bhsd->bhtd', s, vc) + dec[..., None] * jnp.einsum('bhtd,bhde->bhte', qc, c_st)
        den = jnp.sum(s, -1) + dec * jnp.einsum('bhtd,bhd->bht', qc, n_st)
        h = num / jnp.maximum(jnp.abs(den), jnp.exp(-m_t))[..., None]
        b_last = b[..., -1]
        w_s = b_last[..., None] - b + ic
        m_new = jnp.maximum(b_last + m_st, jnp.max(w_s, axis=-1))
        a_s = jnp.exp(w_s - m_new[..., None])
        g_prev = jnp.exp(b_last + m_st - m_new)
        c_new = g_prev[..., None, None] * c_st + jnp.einsum('bhsd,bhse->bhde', a_s[..., None] * kc, vc)
        n_new = g_prev[..., None] * n_st + jnp.einsum('bhs,bhsd->bhd', a_s, kc)
        return (c_new, n_new, m_new), h

    state, hs = lax.scan(step, state, tuple(to_chunks(a) for a in (q, k, v, ig, lf)))
    return jnp.moveaxis(hs, 0, 2).reshape(bsz, nh, t, dh), state


def _mlstm_mixer(hc, hx, rows, w_in, b_in, conv_w, conv_b, hn_g, w_out, need_ctx):
    d = D_MODEL
    f32 = jnp.float32

    def prep(h, conv):
        bsz, n = h.shape[:2]
        p = h @ w_in + b_in
        qk = jax.nn.silu(conv(p[..., :2 * d]))

        def heads(a):
            return jnp.swapaxes(a.reshape(bsz, n, MLSTM_HEADS, MLSTM_DH), 1, 2).astype(f32)
        q = heads(qk[..., :d]) * (MLSTM_DH ** -0.5)
        k = heads(qk[..., d:])
        v = heads(p[..., 2 * d:3 * d])
        o = jax.nn.sigmoid(p[..., 3 * d:4 * d])
        g = jnp.transpose(p[..., 4 * d:].astype(f32).reshape(bsz, n, 4, MLSTM_HEADS), (2, 0, 3, 1))
        return q, k, v, o, g

    def bidir(q, k, v, g, st_f, st_b):
        flip = lambda a: jnp.flip(a, axis=2)
        h_f, st_f = _mlstm_scan(q, k, v, g[0], jax.nn.log_sigmoid(g[2]), st_f)
        h_b, st_b = _mlstm_scan(flip(q), flip(k), flip(v), flip(g[1]), flip(jax.nn.log_sigmoid(g[3])), st_b)
        return h_f + flip(h_b), st_f, st_b

    def finish(h, o):
        bsz, _, n, _ = h.shape
        hn = jnp.swapaxes(_head_norm(h, LN_EPS), 1, 2).reshape(bsz, n, d).astype(o.dtype)
        return (o * hn * hn_g) @ w_out

    bsz = hx.shape[0]
    zero = (jnp.zeros((bsz, MLSTM_HEADS, MLSTM_DH, MLSTM_DH), f32),
            jnp.zeros((bsz, MLSTM_HEADS, MLSTM_DH), f32),
            jnp.full((bsz, MLSTM_HEADS), M_INIT, f32))
    qc, kc, vc, oc, gc = prep(hc, lambda u: _seq_dwconv(u, conv_w, conv_b))
    h_c, st_f, st_b = bidir(qc, kc, vc, gc, zero, zero)
    qx, kx, vx, ox, gx = prep(hx, lambda u: _grid_dwconv(u, conv_w, conv_b, rows))
    h_x, _, _ = bidir(qx, kx, vx, gx, st_f, st_b)
    y_x = finish(h_x, ox)
    y_c = finish(h_c, oc) if need_ctx else None
    return y_c, y_x


def _rwkv7_scan(r, w, k, v, kk, kka, state):
    def step(s, inp):
        r_t, w_t, k_t, v_t, kk_t, kka_t = inp
        sa = jnp.einsum('bhvk,bhk->bhv', s, kk_t)
        s = s * w_t[:, :, None, :] - sa[..., None] * kka_t[:, :, None, :] + v_t[..., None] * k_t[:, :, None, :]
        return s, jnp.einsum('bhvk,bhk->bhv', s, r_t)
    state, ys = lax.scan(step, state, (r, w, k, v, kk, kka))
    return ys, state


def _rwkv7_mixer(hc, hx, rows, mu, w_rkv, w0, w1, w2, a0, a1, a2, g1, g2, k_k, k_a, r_k,
                 lnx_g, lnx_b, w_out, need_ctx):
    f32 = jnp.float32
    d = D_MODEL

    def prep(h, shifted):
        bsz, n, _ = h.shape
        xm = h[None] + (shifted - h)[None] * mu[:, None, None, :]
        r, k, v = jnp.einsum('nbtd,nde->nbte', xm[:3], w_rkv)
        wpre = w0[:, None, None, :] + jnp.einsum(
            'zbte,zed->zbtd', jnp.tanh(jnp.einsum('btd,zde->zbte', xm[3], w1)), w2)
        decay = jnp.exp(-jnp.exp(-jax.nn.softplus(-wpre.astype(f32)) - 0.5))
        a = jax.nn.sigmoid((a0[:, None, None, :] + jnp.einsum(
            'zbte,zed->zbtd', jnp.einsum('btd,zde->zbte', xm[4], a1), a2)).astype(f32))
        g = jax.nn.sigmoid(xm[5] @ g1) @ g2
        kk = (k * k_k).astype(f32).reshape(bsz, n, RWKV_HEADS, RWKV_N)
        kk = (kk / jnp.maximum(jnp.linalg.norm(kk, axis=-1, keepdims=True), 1e-12)).reshape(bsz, n, d)
        ktil = k.astype(f32)[None] * (1.0 + (a - 1.0) * k_a.astype(f32))
        return r, v, g, kk, decay, a, ktil

    def tm(t):
        return jnp.swapaxes(t, 0, 1).reshape(t.shape[1], t.shape[0], RWKV_HEADS, RWKV_N).astype(f32)

    def bidir(pp, st_f, st_b):
        r, v, g, kk, decay, a, ktil = pp
        ins_f = [tm(t) for t in (r, decay[0], ktil[0], v, kk, kk * a[0])]
        ins_b = [jnp.flip(tm(t), 0) for t in (r, decay[1], ktil[1], v, kk, kk * a[1])]
        y_f, st_f = _rwkv7_scan(*ins_f, st_f)
        y_b, st_b = _rwkv7_scan(*ins_b, st_b)
        return y_f + jnp.flip(y_b, 0), st_f, st_b

    def finish(y, pp):
        r, v, g, kk, decay, a, ktil = pp
        n, bsz = y.shape[:2]
        yn = jnp.swapaxes(_head_norm(y, RWKV_GN_EPS), 0, 1).reshape(bsz, n, d) * lnx_g + lnx_b
        kbar = 0.5 * (ktil[0] + ktil[1])
        bonus = jnp.sum((r * kbar * r_k).reshape(bsz, n, RWKV_HEADS, RWKV_N), -1, keepdims=True) \
            * v.reshape(bsz, n, RWKV_HEADS, RWKV_N)
        return ((yn + bonus.reshape(bsz, n, d)) * g).astype(v.dtype) @ w_out

    bsz = hx.shape[0]
    zero = jnp.zeros((bsz, RWKV_HEADS, RWKV_N, RWKV_N), f32)
    pc = prep(hc, _shift_seq(hc))
    y_c, st_f, st_b = bidir(pc, zero, zero)
    px = prep(hx, _qshift_grid(hx, rows))
    y_x, _, _ = bidir(px, st_f, st_b)
    out_x = finish(y_x, px)
    out_c = finish(y_c, pc) if need_ctx else None
    return out_c, out_x


def _peer(h, wq, keys, u_tab, v_tab):
    bsz, n, d = h.shape
    hk = PEER_DQ // 2
    kf = keys.astype(jnp.float32)

    def block(xb):
        nt = xb.shape[0]
        q = (xb @ wq).astype(jnp.float32).reshape(nt, PEER_HEADS, 2, hk)
        s = jnp.einsum('thpd,hpkd->thpk', q, kf)
        sv, si = lax.top_k(s, PEER_TOPK)
        cand = (sv[:, :, 0, :, None] + sv[:, :, 1, None, :]).reshape(nt, PEER_HEADS, PEER_TOPK ** 2)
        cidx = (si[:, :, 0, :, None] * N_KEYS + si[:, :, 1, None, :]).reshape(nt, PEER_HEADS, PEER_TOPK ** 2)
        fv, fi = lax.top_k(cand, PEER_TOPK)
        eidx = jnp.take_along_axis(cidx, fi, axis=-1).reshape(nt, PEER_HEADS * PEER_TOPK)
        gate = jax.nn.softmax(fv, axis=-1).reshape(nt, PEER_HEADS * PEER_TOPK)
        u = jnp.take(u_tab, eidx, axis=0)
        act = jax.nn.gelu(jnp.einsum('ted,td->te', u, xb), approximate=False)
        wgt = (gate * act.astype(jnp.float32)).astype(xb.dtype)
        return jnp.einsum('te,ted->td', wgt, jnp.take(v_tab, eidx, axis=0))

    out = lax.map(block, h.reshape(-1, PEER_BLOCK, d))
    return out.reshape(bsz, n, d)


def setup_inputs(seed: int = 0) -> dict:
    key = jax.random.key(seed)
    ks = iter(jax.random.split(key, 48))
    f32 = jnp.float32
    nrm = lambda shape, scale: jax.random.normal(next(ks), shape, f32) * scale
    d = D_MODEL
    na, nb = N_MLSTM_LAYERS, N_RWKV_LAYERS
    hm = MLSTM_HEADS

    x = nrm((BATCH, SEQ, d), 1.0)
    c = nrm((BATCH, d), 1.0)
    ctx = nrm((BATCH, CTX_LEN, d), 1.0)
    c_ctx = nrm((d,), 1.0)
    ada_w = nrm((DEPTH, d, N_MOD * d), 0.5 * d ** -0.5)
    ada_b = nrm((DEPTH, N_MOD * d), 0.02)
    ln_g = 1.0 + nrm((DEPTH, 2, d), 0.02)
    ln_b = nrm((DEPTH, 2, d), 0.02)

    col_scale = jnp.concatenate([jnp.ones((2 * d,), f32), jnp.full((d,), DN_BETA, f32),
                                 jnp.ones((d,), f32), jnp.full((4 * hm,), 0.5, f32)])
    ml_w_in = nrm((na, d, MLSTM_PROJ), d ** -0.5) * col_scale
    gate_bias = jnp.concatenate([jnp.zeros((2 * hm,), f32), jnp.tile(jnp.linspace(3.0, 6.0, hm), 2)])
    ml_b_in = nrm((na, MLSTM_PROJ), 0.02) + jnp.concatenate([jnp.zeros((4 * d,), f32), gate_bias])
    ml_conv_w = nrm((na, CONV_K, CONV_K, 2 * d), 1.0 / 3.0)
    ml_conv_b = nrm((na, 2 * d), 0.02)
    ml_hn_g = 1.0 + nrm((na, d), 0.02)
    ml_w_out = nrm((na, d, d), d ** -0.5 * DN_BETA)

    rw_mu = jax.random.uniform(next(ks), (nb, 6, d), f32)
    rw_w_rkv = nrm((nb, 3, d, d), d ** -0.5) * jnp.array([1.0, 1.0, DN_BETA], f32)[None, :, None, None]
    rw_w0 = jnp.broadcast_to(jnp.linspace(-6.0, 1.0, d), (nb, 2, d)) + nrm((nb, 2, d), 0.1)
    rw_w1 = nrm((nb, 2, d, DECAY_LORA), d ** -0.5)
    rw_w2 = nrm((nb, 2, DECAY_LORA, d), 0.1 * DECAY_LORA ** -0.5)
    rw_a0 = nrm((nb, 2, d), 0.1)
    rw_a1 = nrm((nb, 2, d, AAA_LORA), d ** -0.5)
    rw_a2 = nrm((nb, 2, AAA_LORA, d), 0.5 * AAA_LORA ** -0.5)
    rw_g1 = nrm((nb, d, GATE_LORA), d ** -0.5)
    rw_g2 = nrm((nb, GATE_LORA, d), GATE_LORA ** -0.5)
    rw_k_k = 0.85 + nrm((nb, d), 0.02)
    rw_k_a = 1.0 + nrm((nb, d), 0.02)
    rw_r_k = nrm((nb, d), 0.1)
    rw_lnx_g = 1.0 + nrm((nb, d), 0.02)
    rw_lnx_b = nrm((nb, d), 0.02)
    rw_w_out = nrm((nb, d, d), d ** -0.5 * DN_BETA)

    pk_wq = nrm((DEPTH, d, PEER_HEADS * PEER_DQ), d ** -0.5)
    pk_keys = nrm((DEPTH, PEER_HEADS, 2, N_KEYS, PEER_DQ // 2), (PEER_DQ // 2) ** -0.5)
    pk_u = nrm((DEPTH, N_EXPERTS, d), d ** -0.5)
    pk_v = nrm((DEPTH, N_EXPERTS, d), DN_BETA)
    return {"x": x, "c": c, "ctx": ctx, "c_ctx": c_ctx,
            "ada_w": ada_w, "ada_b": ada_b, "ln_g": ln_g, "ln_b": ln_b,
            "ml_w_in": ml_w_in, "ml_b_in": ml_b_in, "ml_conv_w": ml_conv_w, "ml_conv_b": ml_conv_b,
            "ml_hn_g": ml_hn_g, "ml_w_out": ml_w_out,
            "rw_mu": rw_mu, "rw_w_rkv": rw_w_rkv, "rw_w0": rw_w0, "rw_w1": rw_w1, "rw_w2": rw_w2,
            "rw_a0": rw_a0, "rw_a1": rw_a1, "rw_a2": rw_a2, "rw_g1": rw_g1, "rw_g2": rw_g2,
            "rw_k_k": rw_k_k, "rw_k_a": rw_k_a, "rw_r_k": rw_r_k, "rw_lnx_g": rw_lnx_g,
            "rw_lnx_b": rw_lnx_b, "rw_w_out": rw_w_out,
            "pk_wq": pk_wq, "pk_keys": pk_keys, "pk_u": pk_u, "pk_v": pk_v}


def reference(x, c, ctx, c_ctx, ada_w, ada_b, ln_g, ln_b,
              ml_w_in, ml_b_in, ml_conv_w, ml_conv_b, ml_hn_g, ml_w_out,
              rw_mu, rw_w_rkv, rw_w0, rw_w1, rw_w2, rw_a0, rw_a1, rw_a2, rw_g1, rw_g2,
              rw_k_k, rw_k_a, rw_r_k, rw_lnx_g, rw_lnx_b, rw_w_out,
              pk_wq, pk_keys, pk_u, pk_v):
    rows = x.shape[1] // GRID_W
    n_ctx = ctx.shape[1]
    s_lat = jax.nn.silu(c)
    s_ctx = jax.nn.silu(c_ctx)
    for i in range(DEPTH):
        last = i == DEPTH - 1
        j = i // N_MIXERS
        mx = jnp.split((s_lat @ ada_w[i] + ada_b[i])[:, None, :], N_MOD, axis=-1)
        mc = jnp.split((s_ctx @ ada_w[i] + ada_b[i])[None, None, :], N_MOD, axis=-1)
        hx = x * (1.0 + mx[1]) + mx[0]
        hc = ctx * (1.0 + mc[1]) + mc[0]
        if i % N_MIXERS == 0:
            yc, yx = _mlstm_mixer(hc, hx, rows, ml_w_in[j], ml_b_in[j], ml_conv_w[j], ml_conv_b[j],
                                  ml_hn_g[j], ml_w_out[j], not last)
        else:
            yc, yx = _rwkv7_mixer(hc, hx, rows, rw_mu[j], rw_w_rkv[j], rw_w0[j], rw_w1[j], rw_w2[j],
                                  rw_a0[j], rw_a1[j], rw_a2[j], rw_g1[j], rw_g2[j], rw_k_k[j],
                                  rw_k_a[j], rw_r_k[j], rw_lnx_g[j], rw_lnx_b[j], rw_w_out[j], not last)
        x = _layernorm(DN_ALPHA * x + mx[2] * yx, ln_g[i, 0], ln_b[i, 0])
        hx = x * (1.0 + mx[4]) + mx[3]
        if last:
            yx = _peer(hx, pk_wq[i], pk_keys[i], pk_u[i], pk_v[i])
        else:
            ctx = _layernorm(DN_ALPHA * ctx + mc[2] * yc, ln_g[i, 0], ln_b[i, 0])
            hc = ctx * (1.0 + mc[4]) + mc[3]
            y = _peer(jnp.concatenate([hc, hx], axis=1), pk_wq[i], pk_keys[i], pk_u[i], pk_v[i])
            ctx = _layernorm(DN_ALPHA * ctx + mc[5] * y[:, :n_ctx], ln_g[i, 1], ln_b[i, 1])
            yx = y[:, n_ctx:]
        x = _layernorm(DN_ALPHA * x + mx[5] * yx, ln_g[i, 1], ln_b[i, 1])
    return x
```

```cpp
#ifndef CPU_EMU
#include <hip/hip_runtime.h>
#include <hip/hip_cooperative_groups.h>
#include <cstdio>
#endif
#ifndef USE_CG_SYNC
#define USE_CG_SYNC 0
#endif
#include <stdint.h>
#include <math.h>

#ifndef PH_MASK
#define PH_MASK 0xffffffffu
#endif
#ifndef DUP_MASK
#define DUP_MASK 0u
#endif
#ifndef REP_GATHER
#define REP_GATHER 1
#endif
#ifndef REP_S4
#define REP_S4 1
#endif
#ifndef REP_S2
#define REP_S2 1
#endif
#ifndef REP_S56
#define REP_S56 1
#endif
#ifndef PEER_FP6
#define PEER_FP6 1
#endif
#ifndef CFG_SEQ
#define CFG_SEQ 16384
#endif
#ifndef CFG_CTX
#define CFG_CTX 256
#endif
#ifndef CFG_DEPTH
#define CFG_DEPTH 4
#endif

namespace {
typedef unsigned short bf16_t;
typedef short bf16x8 __attribute__((ext_vector_type(8)));
typedef float f32x4 __attribute__((ext_vector_type(4)));

constexpr int D = 1024, SEQ = CFG_SEQ, CTX = CFG_CTX, DEPTH = CFG_DEPTH, T = SEQ + CTX, NCH = T / 128, NCC = CTX / 128, ROWS = SEQ / 64;
constexpr int NA = (DEPTH + 1) / 2, NB = DEPTH / 2, NT = 512;
constexpr float DN_ALPHA = 1.681792830507429f;
constexpr int MPROJ = 4 * D + 16;
constexpr int LDS_BYTES = 150528;

constexpr size_t al(size_t x) { return (x + 255) & ~(size_t)255; }
constexpr size_t O_BAR = 0;
constexpr size_t O_MOD = al(O_BAR + 16384);
constexpr size_t O_XS = al(O_MOD + (size_t)DEPTH * 2 * 6144 * 4);
constexpr size_t O_HB = al(O_XS + (size_t)T * D * 4);
constexpr size_t O_GATES = al(O_HB + (size_t)T * D * 2);
constexpr size_t O_WIN = al(O_GATES + (size_t)T * 16 * 4);
constexpr size_t O_WING = al(O_WIN + (size_t)NA * 4096 * 1024 * 2);
constexpr size_t O_WOUTM = al(O_WING + (size_t)NA * 16 * 1024 * 4);
constexpr size_t O_WRKV = al(O_WOUTM + (size_t)NA * 1024 * 1024 * 2);
constexpr size_t O_W1C = al(O_WRKV + (size_t)NB * 3 * 1024 * 1024 * 2);
constexpr size_t O_A1C = al(O_W1C + (size_t)NB * 128 * 1024 * 2);
constexpr size_t O_G1 = al(O_A1C + (size_t)NB * 128 * 1024 * 2);
constexpr size_t O_W2 = al(O_G1 + (size_t)NB * 256 * 1024 * 2);
constexpr size_t O_A2 = al(O_W2 + (size_t)NB * 2 * 1024 * 64 * 2);
constexpr size_t O_G2 = al(O_A2 + (size_t)NB * 2 * 1024 * 64 * 2);
constexpr size_t O_WOUTR = al(O_G2 + (size_t)NB * 1024 * 192 * 2);
constexpr size_t O_WQ = al(O_WOUTR + (size_t)NB * 1024 * 1024 * 2);
constexpr size_t O_KEYS = al(O_WQ + (size_t)DEPTH * 2048 * 1024 * 2);
constexpr size_t O_UT = al(O_KEYS + (size_t)DEPTH * 16 * 128 * 128 * 2);
constexpr size_t O_VT2 = al(O_UT + (size_t)16384 * 1024);
constexpr size_t O_US = al(O_VT2 + (size_t)16384 * 1024);
constexpr size_t O_VS = al(O_US + (size_t)16384 * 4);
constexpr size_t O_WINGB = al(O_VS + (size_t)16384 * 4);
constexpr size_t O_CROW = al(O_WINGB + (size_t)NA * 128 * 1024 * 2);
constexpr size_t O_SCR = al(O_CROW + (size_t)DEPTH * 4 * 1024 * 2);
constexpr size_t M_PQK = O_SCR;
constexpr size_t M_VB = al(M_PQK + (size_t)T * 2048 * 2);
constexpr size_t M_OB = al(M_VB + (size_t)T * D * 2);
constexpr size_t M_QB = al(M_OB + (size_t)T * D * 2);
constexpr size_t M_KB = al(M_QB + (size_t)T * D * 2);
constexpr size_t M_KAT = al(M_KB + (size_t)T * D * 2);
constexpr size_t M_VT = al(M_KAT + (size_t)2 * D * T * 2);
constexpr size_t M_BCUM = al(M_VT + (size_t)D * T * 2);
constexpr size_t M_AS = al(M_BCUM + (size_t)8 * T * 4);
constexpr size_t M_PMAX = al(M_AS + (size_t)8 * T * 4);
constexpr size_t M_MLOC = al(M_PMAX + (size_t)8 * T * 4);
constexpr size_t M_BLAST = al(M_MLOC + (size_t)8 * NCH * 4);
constexpr size_t M_MIN = al(M_BLAST + (size_t)8 * NCH * 4);
constexpr size_t M_NIN = al(M_MIN + (size_t)8 * NCH * 4);
constexpr size_t M_NLOC = al(M_NIN + (size_t)8 * NCH * 256 * 4);
constexpr size_t M_KVLOC = al(M_NLOC + (size_t)8 * NCH * 256 * 4);
constexpr size_t M_CIN = al(M_KVLOC + (size_t)8 * NCH * 65536 * 2);
constexpr size_t M_PBUF = al(M_CIN + (size_t)8 * NCH * 65536 * 2);
constexpr size_t M_QF = al(M_PBUF + (size_t)4 * NCH * 16384 * 2);
constexpr size_t M_QBW = al(M_QF + (size_t)T * D * 2);
constexpr size_t M_END = al(M_QBW + (size_t)T * D * 2);
constexpr size_t R_XM = O_SCR;
constexpr size_t R_RB = al(R_XM + (size_t)6 * T * D * 2);
constexpr size_t R_KB = al(R_RB + (size_t)T * D * 2);
constexpr size_t R_VB = al(R_KB + (size_t)T * D * 2);
constexpr size_t R_LW1 = al(R_VB + (size_t)T * D * 2);
constexpr size_t R_LA1 = al(R_LW1 + (size_t)T * 128 * 2);
constexpr size_t R_LG1 = al(R_LA1 + (size_t)T * 128 * 2);
constexpr size_t R_WDEC = al(R_LG1 + (size_t)T * 192 * 2);
constexpr size_t R_AA = al(R_WDEC + (size_t)2 * T * D * 4);
constexpr size_t R_GG = al(R_AA + (size_t)2 * T * D * 2);
constexpr size_t R_OUTB = al(R_GG + (size_t)T * D * 2);
constexpr int NC64 = T / 64;
constexpr size_t R_MT = al(R_OUTB + (size_t)T * D * 2);
constexpr size_t R_NN = al(R_MT + (size_t)32 * NC64 * 4096 * 2);
constexpr size_t R_RP = al(R_NN + (size_t)32 * NC64 * 4096 * 4);
constexpr size_t R_END = al(R_RP + (size_t)32 * NC64 * 4096 * 2);
constexpr size_t P_QP = O_SCR;
constexpr size_t P_TK = al(P_QP + (size_t)T * 2048 * 2);
constexpr size_t P_EIDX = al(P_TK + (size_t)T * 256 * 4);
constexpr size_t P_GATE = al(P_EIDX + (size_t)T * 128 * 4);
constexpr size_t P_END = al(P_GATE + (size_t)T * 128 * 4);
constexpr size_t WS_NEED = (M_END > R_END ? (M_END > P_END ? M_END : P_END) : (R_END > P_END ? R_END : P_END));
static_assert(M_KVLOC + (size_t)T * D * 4 <= M_CIN, "Y alias must fit in KVLOC");
static_assert((size_t)T * 2048 * 2 == (size_t)T * D * 4, "HOUT alias");

struct Params {
    const float* in[34];
    float* out;
    unsigned char* ws;
};
constexpr int PTR_TAB = LDS_BYTES - 16 - 40 * 8;

#ifdef CPU_EMU
__device__ __forceinline__ float u2f(unsigned u) { float f; memcpy(&f, &u, 4); return f; }
__device__ __forceinline__ unsigned f2u(float f) { unsigned u; memcpy(&u, &f, 4); return u; }
#define SMEM_DECL unsigned char* smem = emu_smem()
__device__ __forceinline__ f32x4 mfma16(bf16x8 a, bf16x8 b, f32x4 c) { return emu_mfma16(a, b, c); }
#else
__device__ __forceinline__ float u2f(unsigned u) { return __uint_as_float(u); }
__device__ __forceinline__ unsigned f2u(float f) { return __float_as_uint(f); }
#define SMEM_DECL unsigned char* smem = smem_base()
__device__ __forceinline__ f32x4 mfma16(bf16x8 a, bf16x8 b, f32x4 c) { return __builtin_amdgcn_mfma_f32_16x16x32_bf16(a, b, c, 0, 0, 0); }
#endif
__device__ __forceinline__ float bf2f(bf16_t h) { return u2f((unsigned)h << 16); }
#ifdef CPU_EMU
__device__ __forceinline__ bf16_t f2bf(float f) { unsigned u = f2u(f); u += 0x7fffu + ((u >> 16) & 1u); return (bf16_t)(u >> 16); }
__device__ __forceinline__ unsigned pack2(float lo, float hi) { return (unsigned)f2bf(lo) | ((unsigned)f2bf(hi) << 16); }
#else
typedef __bf16 bf16x2_hw __attribute__((ext_vector_type(2)));
typedef float f32x2_hw __attribute__((ext_vector_type(2)));
__device__ __forceinline__ unsigned pack2(float lo, float hi) { const f32x2_hw v = {lo, hi}; return __builtin_bit_cast(unsigned, __builtin_convertvector(v, bf16x2_hw)); }
__device__ __forceinline__ bf16_t f2bf(float f) { return (bf16_t)(pack2(f, f) & 0xffffu); }
#endif
__device__ __forceinline__ float bflo(unsigned u) { return u2f(u << 16); }
__device__ __forceinline__ float bfhi(unsigned u) { return u2f(u & 0xffff0000u); }
#ifdef CPU_EMU
__device__ __forceinline__ float fexp(float x) { return expf(x); }
#else
__device__ __forceinline__ float fexp(float x) { return __expf(x); }
#endif
__device__ __forceinline__ float sigmoidf_(float x) { return 1.f / (1.f + expf(-x)); }
__device__ __forceinline__ float siluf_(float x) { return x / (1.f + expf(-x)); }
__device__ __forceinline__ float ftanh(float x) { const float e = fexp(-2.f * fabsf(x)); const float t = (1.f - e) / (1.f + e); return x < 0.f ? -t : t; }
__device__ __forceinline__ float wave_sum(float v) {
#pragma unroll
    for (int m = 32; m >= 1; m >>= 1) v += __shfl_xor(v, m);
    return v;
}
__device__ __forceinline__ float wave_max(float v) {
#pragma unroll
    for (int m = 32; m >= 1; m >>= 1) v = fmaxf(v, __shfl_xor(v, m));
    return v;
}
#ifdef CPU_EMU
__device__ __forceinline__ float fp8_dec(unsigned b) {
    const unsigned s = b >> 7, e = (b >> 3) & 15, m = b & 7; float v;
    if (e == 0) v = ldexpf((float)m, -9); else v = ldexpf(1.f + m / 8.f, (int)e - 7);
    return s ? -v : v;
}
__device__ __forceinline__ unsigned fp8_enc(float f) {
    const unsigned s = f < 0.f ? 0x80u : 0u; float a = fabsf(f); if (!(a < 448.f)) return s | 0x7Eu;
    if (a < ldexpf(1.f, -6)) { const int q = (int)rintf(a * 512.f); return s | (unsigned)q; }
    int e; const float fr = frexpf(a, &e); e -= 1;
    int m = (int)rintf((2.f * fr - 1.f) * 8.f); if (m == 8) { m = 0; e += 1; }
    unsigned c = (unsigned)((e + 7) << 3) | (unsigned)m; if (c > 0x7Eu) c = 0x7Eu;
    return s | c;
}
__device__ __forceinline__ void fp8x16_dec(uint4 u, float* f) {
    const unsigned w[4] = {u.x, u.y, u.z, u.w};
    for (int i = 0; i < 16; ++i) f[i] = fp8_dec((w[i >> 2] >> (8 * (i & 3))) & 255u);
}
__device__ __forceinline__ uint4 fp8x16_enc(const float* f) {
    unsigned w[4] = {0, 0, 0, 0};
    for (int i = 0; i < 16; ++i) w[i >> 2] |= fp8_enc(f[i]) << (8 * (i & 3));
    return make_uint4(w[0], w[1], w[2], w[3]);
}
__device__ __forceinline__ float wave_sum_fast(float v) { return wave_sum(v); }
#else
typedef float f32x2_t __attribute__((ext_vector_type(2)));
__device__ __forceinline__ void fp8x4_dec(unsigned w, float* f) {
    const f32x2_t a = __builtin_amdgcn_cvt_pk_f32_fp8((int)w, false), b = __builtin_amdgcn_cvt_pk_f32_fp8((int)w, true);
    f[0] = a[0]; f[1] = a[1]; f[2] = b[0]; f[3] = b[1];
}
__device__ __forceinline__ void fp8x16_dec(uint4 u, float* f) { fp8x4_dec(u.x, f); fp8x4_dec(u.y, f + 4); fp8x4_dec(u.z, f + 8); fp8x4_dec(u.w, f + 12); }
__device__ __forceinline__ unsigned fp8x4_enc(const float* f) {
    int w = 0;
    w = __builtin_amdgcn_cvt_pk_fp8_f32(f[0], f[1], w, false);
    w = __builtin_amdgcn_cvt_pk_fp8_f32(f[2], f[3], w, true);
    return (unsigned)w;
}
__device__ __forceinline__ uint4 fp8x16_enc(const float* f) { return make_uint4(fp8x4_enc(f), fp8x4_enc(f + 4), fp8x4_enc(f + 8), fp8x4_enc(f + 12)); }
__device__ __forceinline__ float wave_sum_fast(float v) {
    v += __int_as_float(__builtin_amdgcn_update_dpp(0, __float_as_int(v), 0xB1, 0xF, 0xF, true));
    v += __int_as_float(__builtin_amdgcn_update_dpp(0, __float_as_int(v), 0x4E, 0xF, 0xF, true));
    v += __int_as_float(__builtin_amdgcn_update_dpp(0, __float_as_int(v), 0x141, 0xF, 0xF, true));
    v += __int_as_float(__builtin_amdgcn_update_dpp(0, __float_as_int(v), 0x140, 0xF, 0xF, true));
    v += __int_as_float(__builtin_amdgcn_update_dpp(0, __float_as_int(v), 0x142, 0xA, 0xF, false));
    v += __int_as_float(__builtin_amdgcn_update_dpp(0, __float_as_int(v), 0x143, 0xC, 0xF, false));
    return __int_as_float(__builtin_amdgcn_readlane(__float_as_int(v), 63));
}
#endif
__device__ __forceinline__ unsigned fp6_enc(float f) {
    const unsigned s = f < 0.f ? 32u : 0u; const float a = fminf(fabsf(f), 7.5f);
    float c;
    if (a < 2.f) c = rintf(a * 8.f);
    else if (a < 4.f) c = 16.f + rintf((a - 2.f) * 4.f);
    else c = 24.f + rintf((a - 4.f) * 2.f);
    unsigned code = (unsigned)c; if (code > 31u) code = 31u;
    return s | code;
}
typedef unsigned u32x6 __attribute__((ext_vector_type(6)));
typedef float f32x32 __attribute__((ext_vector_type(32)));
__device__ __forceinline__ void fp6x32_pack(const float* f, unsigned* w) {
#pragma unroll
    for (int k = 0; k < 6; ++k) w[k] = 0u;
#pragma unroll
    for (int i = 0; i < 32; ++i) { const unsigned c = fp6_enc(f[i]); const int bit = 6 * i, k = bit >> 5, sh = bit & 31; w[k] |= c << sh; if (sh > 26) w[k + 1] |= c >> (32 - sh); }
}
#ifdef CPU_EMU
__device__ __forceinline__ void fp6x32_dec(const unsigned* w, float* f) {
    for (int i = 0; i < 32; ++i) { const int bit = 6 * i, k = bit >> 5, sh = bit & 31; unsigned c = w[k] >> sh; if (sh > 26) c |= w[k + 1] << (32 - sh); c &= 63u;
        const unsigned e = (c >> 3) & 3u, m = c & 7u; const float v = e == 0 ? m * 0.125f : (1.f + m * 0.125f) * (float)(1 << (e - 1)); f[i] = (c & 32u) ? -v : v; }
}
#else
__device__ __forceinline__ void fp6x32_dec(const unsigned* w, float* f) {
    const u32x6 src = {w[0], w[1], w[2], w[3], w[4], w[5]};
    const f32x32 r = __builtin_amdgcn_cvt_scalef32_pk32_f32_fp6(src, 1.0f);
#pragma unroll
    for (int i = 0; i < 32; ++i) f[i] = r[i];
}
#endif
__device__ __forceinline__ void unpack8(uint4 u, float* f) {
    f[0] = bflo(u.x); f[1] = bfhi(u.x); f[2] = bflo(u.y); f[3] = bfhi(u.y); f[4] = bflo(u.z); f[5] = bfhi(u.z); f[6] = bflo(u.w); f[7] = bfhi(u.w);
}
__device__ __forceinline__ uint4 pack8(const float* f) { return make_uint4(pack2(f[0], f[1]), pack2(f[2], f[3]), pack2(f[4], f[5]), pack2(f[6], f[7])); }


#ifdef CPU_EMU
__device__ __forceinline__ unsigned char* smem_base() { return emu_smem(); }
#else
__device__ __forceinline__ unsigned char* smem_base() { extern __shared__ __attribute__((aligned(16))) unsigned char smem_dyn[]; return smem_dyn; }
#endif
struct KP {
    const Params* kp; unsigned char* ws; unsigned char* sm; int tid, bid, G;
    __device__ __forceinline__ const float* in(int i) const { return kp->in[i]; }
    __device__ __forceinline__ float* out() const { return kp->out; }
};
__device__ __forceinline__ KP fresh(const Params& kp) {
    KP r; r.kp = &kp; r.ws = kp.ws; r.sm = smem_base();
    r.tid = threadIdx.x; r.bid = blockIdx.x; r.G = gridDim.x;
#ifndef CPU_EMU
    asm volatile("" : "+v"(r.tid)); asm volatile("" : "+s"(r.bid)); asm volatile("" : "+s"(r.G));
    { size_t zero = 0; asm volatile("" : "+s"(zero)); r.ws = kp.ws + zero; }
#endif
    return r;
}
#ifdef CPU_EMU
struct GridBar { int dummy; };
__device__ __forceinline__ GridBar gridbar_init(unsigned*, unsigned char*) { return GridBar{0}; }
__device__ __forceinline__ void grid_sync(const Params&) { emu_gridsync(); }
#else
#define XB_TMO      128
#define XB_XCNT(j)  (256  + 64 * (j))
#define XB_XSUB(j)  (1280 + 64 * (j))
#define XB_XGEN(j)  (2304 + 64 * (j))
#define XB_TOP      3328
#define XB_TOPGEN   3392
#define XCD_BAR_WORDS 3456
#define XB_SPIN_CAP (1u << 28)
#define LAS __attribute__((address_space(3)))
__device__ __forceinline__ unsigned xb_ld(unsigned* p) { return __hip_atomic_load(p, __ATOMIC_RELAXED, __HIP_MEMORY_SCOPE_AGENT); }
__device__ __forceinline__ unsigned xb_add(unsigned* p, unsigned v) { return __hip_atomic_fetch_add(p, v, __ATOMIC_RELAXED, __HIP_MEMORY_SCOPE_AGENT); }
__device__ __forceinline__ unsigned xb_xcc_id() { return (unsigned)__builtin_amdgcn_s_getreg((3 << 11) | 20) & 0xFu; }
#define XB_SPIN(cond, bar) do { unsigned _sp = 0; while (cond) { __builtin_amdgcn_s_sleep(1); \
    if ((++_sp & 255u) == 0u) { if (xb_ld(&(bar)[XB_TMO])) break; if (_sp > XB_SPIN_CAP) { atomicAdd(&(bar)[XB_TMO], 1u); break; } } } } while (0)
struct GridBar { unsigned* bar; unsigned x; volatile LAS unsigned* st; };
__device__ __forceinline__ GridBar gridbar_init(unsigned* bar, unsigned char* smem_words) {
    GridBar b; b.bar = bar; b.x = xb_xcc_id(); b.st = (volatile LAS unsigned*)smem_words;
    if (threadIdx.x == 0) { b.st[0] = 0u; b.st[1] = 0u; (void)xb_add(&bar[XB_XCNT(b.x)], 1u); }
    __syncthreads();
    return b;
}
__device__ __forceinline__ void xcd_barrier_complete(unsigned* bar, unsigned x, unsigned& nloc, unsigned& nx) {
    const unsigned G = gridDim.x;
    unsigned sum, cnt, mine, sp = 0u;
    for (;;) {
        sum = 0u; cnt = 0u; mine = 0u;
#pragma unroll
        for (unsigned j = 0; j < 16; ++j) { const unsigned c = xb_ld(&bar[XB_XCNT(j)]); sum += c; cnt += (c > 0u) ? 1u : 0u; mine = (j == x) ? c : mine; }
        if (sum == G) break;
        __builtin_amdgcn_s_sleep(1);
        if ((++sp & 255u) == 0u) { if (xb_ld(&bar[XB_TMO])) break; if (sp > XB_SPIN_CAP) { atomicAdd(&bar[XB_TMO], 1u); break; } }
    }
    nloc = mine > 0u ? mine : 1u; nx = cnt > 0u ? cnt : 1u;
}
__device__ __forceinline__ void grid_sync(const Params& kp_) {
    GridBar b; b.bar = (unsigned*)(kp_.ws + O_BAR); b.x = xb_xcc_id(); b.st = (volatile LAS unsigned*)(smem_base() + LDS_BYTES - 16);
#if USE_CG_SYNC
    cooperative_groups::this_grid().sync();
    return;
#endif
    asm volatile("s_waitcnt vmcnt(0)" ::: "memory");
    __syncthreads();
    if (threadIdx.x == 0) {
        unsigned* bar = b.bar;
        __builtin_amdgcn_s_waitcnt(0);
        unsigned nloc = b.st[0], nx = b.st[1];
        if (nloc == 0u) { xcd_barrier_complete(bar, b.x, nloc, nx); b.st[0] = nloc; b.st[1] = nx; }
        const unsigned old = xb_add(&bar[XB_XSUB(b.x)], 1u);
        const unsigned gen = old / nloc;
        if (old + 1u == (gen + 1u) * nloc) {
            __builtin_amdgcn_fence(__ATOMIC_RELEASE, "agent");
            asm volatile("s_waitcnt vmcnt(0)" ::: "memory");
            const unsigned og = xb_add(&bar[XB_TOP], 1u);
            const unsigned tg = og / nx;
            if (og + 1u == (tg + 1u) * nx) xb_add(&bar[XB_TOPGEN], 1u);
            else XB_SPIN(xb_ld(&bar[XB_TOPGEN]) == tg, bar);
            __builtin_amdgcn_fence(__ATOMIC_ACQUIRE, "agent");
            xb_add(&bar[XB_XGEN(b.x)], 1u);
            asm volatile("s_waitcnt vmcnt(0)" ::: "memory");
        } else {
            XB_SPIN(xb_ld(&bar[XB_XGEN(b.x)]) == gen, bar);
            __builtin_amdgcn_fence(__ATOMIC_ACQUIRE, "agent");
            asm volatile("s_waitcnt vmcnt(0)" ::: "memory");
        }
    }
    __syncthreads();
}
#endif

#ifdef CPU_EMU
#define LDS_BARRIER() __syncthreads()
#else
#define LDS_BARRIER() do { asm volatile("s_waitcnt lgkmcnt(0)" ::: "memory"); __builtin_amdgcn_s_barrier(); asm volatile("" ::: "memory"); } while (0)
#endif
constexpr int LSTR = 72;
struct Seg { const bf16_t* A; long lda; const bf16_t* B; long ldb; int K; };
__device__ __forceinline__ void gemm_core(const int tid, const Seg& s0, const Seg& s1, const Seg& s2, unsigned char* smem, f32x4 (&acc)[4][2]) {
    const int lane = tid & 63, wid = tid >> 6, wm = wid >> 2, wn = wid & 3;
    bf16_t* sA = (bf16_t*)smem; bf16_t* sB = sA + 128 * LSTR;
    const int lr = tid >> 3, lc = (tid & 7) * 8;
#pragma unroll
    for (int i = 0; i < 4; ++i)
#pragma unroll
        for (int j = 0; j < 2; ++j) acc[i][j] = (f32x4){0.f, 0.f, 0.f, 0.f};
    const int nsteps = (s0.K + s1.K + s2.K) >> 6;
    uint4 ra0, ra1, rb0, rb1;
    auto gload = [&](int s) {
        int kk = s * 64; const bf16_t* Ap; const bf16_t* Bp; long la, lb;
        if (kk < s0.K) { Ap = s0.A + kk; Bp = s0.B + kk; la = s0.lda; lb = s0.ldb; }
        else if (kk < s0.K + s1.K) { kk -= s0.K; Ap = s1.A + kk; Bp = s1.B + kk; la = s1.lda; lb = s1.ldb; }
        else { kk -= s0.K + s1.K; Ap = s2.A + kk; Bp = s2.B + kk; la = s2.lda; lb = s2.ldb; }
        ra0 = *(const uint4*)(Ap + (long)lr * la + lc); ra1 = *(const uint4*)(Ap + (long)(lr + 64) * la + lc);
        rb0 = *(const uint4*)(Bp + (long)lr * lb + lc); rb1 = *(const uint4*)(Bp + (long)(lr + 64) * lb + lc);
    };
    gload(0);
    for (int s = 0; s < nsteps; ++s) {
        LDS_BARRIER();
        *(uint4*)(sA + lr * LSTR + lc) = ra0; *(uint4*)(sA + (lr + 64) * LSTR + lc) = ra1;
        *(uint4*)(sB + lr * LSTR + lc) = rb0; *(uint4*)(sB + (lr + 64) * LSTR + lc) = rb1;
        LDS_BARRIER();
        if (s + 1 < nsteps) gload(s + 1);
#pragma unroll
        for (int ks = 0; ks < 2; ++ks) {
            bf16x8 af[4], bfr[2];
#pragma unroll
            for (int mt = 0; mt < 4; ++mt) af[mt] = *(const bf16x8*)(sA + (wm * 64 + mt * 16 + (lane & 15)) * LSTR + ks * 32 + (lane >> 4) * 8);
#pragma unroll
            for (int nt = 0; nt < 2; ++nt) bfr[nt] = *(const bf16x8*)(sB + (wn * 32 + nt * 16 + (lane & 15)) * LSTR + ks * 32 + (lane >> 4) * 8);
#pragma unroll
            for (int mt = 0; mt < 4; ++mt)
#pragma unroll
                for (int nt = 0; nt < 2; ++nt) acc[mt][nt] = mfma16(bfr[nt], af[mt], acc[mt][nt]);
        }
    }
    LDS_BARRIER();
}
#define ACC_FOREACH(...) { const int _lane = p.tid & 63, _wid = p.tid >> 6, _wm = _wid >> 2, _wn = _wid & 3; \
    _Pragma("unroll") for (int _mt = 0; _mt < 4; ++_mt) _Pragma("unroll") for (int _nt = 0; _nt < 2; ++_nt) { \
        const int m = _wm * 64 + _mt * 16 + (_lane & 15), n = _wn * 32 + _nt * 16 + (_lane >> 4) * 4; const f32x4 v = acc[_mt][_nt]; __VA_ARGS__ } }
__device__ __forceinline__ Seg mkseg(const bf16_t* A, long lda, const bf16_t* B, long ldb, int K) { Seg s; s.A = A; s.lda = lda; s.B = B; s.ldb = ldb; s.K = K; return s; }
__device__ __forceinline__ void st_bf4(bf16_t* p, float a, float b, float c, float d) { *(uint2*)p = make_uint2(pack2(a, b), pack2(c, d)); }
__device__ __forceinline__ void st_f4(float* p, float a, float b, float c, float d) { *(float4*)p = make_float4(a, b, c, d); }

#ifdef CPU_EMU
#define PG8_LAS
#define PG8_GLDS(src, dst) memcpy((unsigned char*)(dst) + (threadIdx.x & 63) * 16, (const void*)(src), 16)
#define PG8_RFL(x) (x)
#define PG8_WAIT_V(n)
#define PG8_WAIT_L(n)
#define PG8_BAR __syncthreads()
#define PG8_SCHED
#define PG8_PRIO(x)
#else
#define PG8_LAS __attribute__((address_space(3)))
#define PG8_GLDS(src, dst) __builtin_amdgcn_global_load_lds((const unsigned*)(src), (PG8_LAS unsigned*)(dst), 16, 0, 0)
#define PG8_RFL(x) __builtin_amdgcn_readfirstlane(x)
#define PG8_WAIT_V(n) asm volatile("s_waitcnt vmcnt(" #n ")" ::: "memory")
#define PG8_WAIT_L(n) asm volatile("s_waitcnt lgkmcnt(" #n ")" ::: "memory")
#define PG8_BAR __builtin_amdgcn_s_barrier()
#define PG8_SCHED __builtin_amdgcn_sched_barrier(0)
#define PG8_PRIO(x) __builtin_amdgcn_s_setprio(x)
#endif
namespace pg8 {
constexpr int BM = 256, BK = 64, HALF = 128, HTB = HALF * BK * 2, NXCD = 8, WGM = 8;
__device__ __forceinline__ int lds_byte(int r, int c) { const int st = (r >> 4) * 2 + (c >> 5), rr = r & 15, cc = c & 31, ob = rr * 64 + cc * 2; return st * 1024 + (ob ^ (((ob >> 9) & 1) << 5)); }
__device__ __forceinline__ void stage_rc(int b, int& R, int& C) { const int st = b / 1024, sb = b % 1024, swz = sb ^ (((sb >> 9) & 1) << 5); R = (st >> 1) * 16 + swz / 64; C = (st & 1) * 32 + (swz % 64) / 2; }
struct Unit { int pm, pn; };
struct Gemm { const bf16_t* A; const bf16_t* Bt; int M, N, K; };
struct StaticOrder {
    int nM, nN, nwg, G, c;
    __device__ __forceinline__ void init(int M, int N, int G_, int c_) { nM = M / BM; nN = N / BM; nwg = nM * nN; G = G_; c = c_; }
    __device__ __forceinline__ bool next(int i, Unit& u) const {
        const long L = (long)i * G + c; if (L >= nwg) return false;
        int wgid = (int)L; { const int q = nwg / NXCD, r = nwg % NXCD, xcd = wgid % NXCD, off = wgid / NXCD; wgid = (xcd < r ? xcd * (q + 1) : r * (q + 1) + (xcd - r) * q) + off; }
        const int nig = WGM * nN, gid = wgid / nig, fm = gid * WGM, gsz = (nM - fm) < WGM ? (nM - fm) : WGM;
        u.pm = fm + ((wgid % nig) % gsz); u.pn = (wgid % nig) / gsz; return true;
    }
};
template <class Epi>
__device__ __forceinline__ void gemm_phase(PG8_LAS unsigned char* lds, const int tid, const Gemm g, const StaticOrder& S, const Epi& E) {
    const int wid = PG8_RFL(tid >> 6), lane = tid & 63, wr = wid >> 2, wc = wid & 3, fr = lane & 15, fq = lane >> 4;
    const int K = g.K, nt = K / BK;
    unsigned voffA[2];
#pragma unroll
    for (int i = 0; i < 2; ++i) { int R, C; stage_rc(tid * 16 + i * 8192, R, C); voffA[i] = (unsigned)(R * K + C) * 2u; }
    const size_t kstep = (size_t)(BK * 2), hstep = (size_t)HALF * K * 2, tstep = 2 * hstep;
    const unsigned ldsw = (unsigned)wid * 1024u;
    const int aoff = lds_byte(wr * 64 + fr, fq * 8), boff = lds_byte(wc * 32 + fr, fq * 8);
#define PG8_SA(b, h) (((b) * 2 + (h)) * HTB)
#define PG8_SB(b, h) ((4 + (b) * 2 + (h)) * HTB)
#define PG8_STAGE(bufoff, gbase) do { _Pragma("unroll") for (int _i = 0; _i < 2; ++_i) PG8_GLDS((const char*)(gbase) + voffA[_i], lds + (bufoff) + ldsw + _i * 8192); } while (0)
#define PG8_LDA(dst, b, h) do { _Pragma("unroll") for (int m = 0; m < 4; ++m) _Pragma("unroll") for (int k = 0; k < 2; ++k) dst[m][k] = *(const PG8_LAS bf16x8*)(lds + PG8_SA(b, h) + aoff + m * 2048 + k * 1024); } while (0)
#define PG8_LDB(dst, b, h) do { _Pragma("unroll") for (int n = 0; n < 2; ++n) _Pragma("unroll") for (int k = 0; k < 2; ++k) dst[n][k] = *(const PG8_LAS bf16x8*)(lds + PG8_SB(b, h) + boff + n * 2048 + k * 1024); } while (0)
#define PG8_MMA(ai, bj, At, Bt) do { PG8_PRIO(1); _Pragma("unroll") for (int m = 0; m < 4; ++m) _Pragma("unroll") for (int n = 0; n < 2; ++n) _Pragma("unroll") for (int k = 0; k < 2; ++k) \
        acc[ai][bj][m][n] = mfma16(Bt[n][k], At[m][k], acc[ai][bj][m][n]); PG8_PRIO(0); } while (0)
    Unit cur, nxt; int ui = 0;
    if (!S.next(0, cur)) return;
    f32x4 acc[2][2][4][2];
#pragma unroll
    for (int a = 0; a < 2; ++a)
#pragma unroll
        for (int b = 0; b < 2; ++b)
#pragma unroll
            for (int m = 0; m < 4; ++m)
#pragma unroll
                for (int n = 0; n < 2; ++n) acc[a][b][m][n] = (f32x4){0.f, 0.f, 0.f, 0.f};
    bf16x8 At[4][2], B0[2][2], B1[2][2];
    const char* cA = (const char*)g.A + (size_t)cur.pm * tstep; const char* cB = (const char*)g.Bt + (size_t)cur.pn * tstep;
    PG8_STAGE(PG8_SB(0, 0), cB); PG8_STAGE(PG8_SA(0, 0), cA); PG8_STAGE(PG8_SB(0, 1), cB + hstep); PG8_STAGE(PG8_SA(0, 1), cA + hstep);
    if (wr == 1) PG8_BAR;
    PG8_WAIT_V(4); PG8_BAR;
    PG8_STAGE(PG8_SB(1, 0), cB + kstep); PG8_STAGE(PG8_SA(1, 0), cA + kstep); PG8_STAGE(PG8_SB(1, 1), cB + hstep + kstep);
    PG8_WAIT_V(6); PG8_BAR;
    for (;;) {
        const bool has_next = S.next(ui + 1, nxt);
        const char* nA = has_next ? (const char*)g.A + (size_t)nxt.pm * tstep : cA; const char* nB = has_next ? (const char*)g.Bt + (size_t)nxt.pn * tstep : cB;
        for (int t = 0; t < nt; t += 2) {
            const bool last = (t == nt - 2);
            const char* a1 = cA + (size_t)(t + 1) * kstep;
            const char* a2 = last ? nA : cA + (size_t)(t + 2) * kstep; const char* b2 = last ? nB : cB + (size_t)(t + 2) * kstep;
            const char* a3 = a2 + kstep; const char* b3 = b2 + kstep;
            PG8_LDB(B0, 0, 0); PG8_SCHED; PG8_LDA(At, 0, 0); PG8_STAGE(PG8_SA(1, 1), a1 + hstep);
            PG8_WAIT_L(8); PG8_BAR; PG8_WAIT_L(0); PG8_MMA(0, 0, At, B0); PG8_BAR; PG8_SCHED;
            PG8_LDB(B1, 0, 1); PG8_STAGE(PG8_SB(0, 0), b2);
            PG8_BAR; PG8_WAIT_L(0); PG8_MMA(0, 1, At, B1); PG8_BAR;
            PG8_LDA(At, 0, 1); PG8_STAGE(PG8_SA(0, 0), a2);
            PG8_BAR; PG8_WAIT_L(0); PG8_MMA(1, 0, At, B0); PG8_BAR; PG8_SCHED;
            PG8_STAGE(PG8_SB(0, 1), b2 + hstep);
            PG8_WAIT_V(6); PG8_BAR; PG8_MMA(1, 1, At, B1); PG8_BAR;
            PG8_LDB(B0, 1, 0); PG8_SCHED; PG8_LDA(At, 1, 0); PG8_STAGE(PG8_SA(0, 1), a2 + hstep);
            PG8_WAIT_L(8); PG8_BAR; PG8_WAIT_L(0); PG8_MMA(0, 0, At, B0); PG8_BAR; PG8_SCHED;
            PG8_LDB(B1, 1, 1); PG8_STAGE(PG8_SB(1, 0), b3);
            PG8_BAR; PG8_WAIT_L(0); PG8_MMA(0, 1, At, B1); PG8_BAR;
            PG8_LDA(At, 1, 1); PG8_STAGE(PG8_SA(1, 0), a3);
            PG8_BAR; PG8_WAIT_L(0); PG8_MMA(1, 0, At, B0); PG8_BAR; PG8_SCHED;
            PG8_STAGE(PG8_SB(1, 1), b3 + hstep);
            PG8_WAIT_V(6); PG8_BAR; PG8_MMA(1, 1, At, B1); PG8_BAR;
        }
        E(acc, cur, wr, wc, fr, fq);
        if (!has_next) break;
#pragma unroll
        for (int a = 0; a < 2; ++a)
#pragma unroll
            for (int b = 0; b < 2; ++b)
#pragma unroll
                for (int m = 0; m < 4; ++m)
#pragma unroll
                    for (int n = 0; n < 2; ++n) acc[a][b][m][n] = (f32x4){0.f, 0.f, 0.f, 0.f};
        cur = nxt; cA = nA; cB = nB; ++ui;
    }
    PG8_WAIT_V(0);
    if (wr == 0) PG8_BAR;
    PG8_BAR;
#undef PG8_SA
#undef PG8_SB
#undef PG8_STAGE
#undef PG8_LDA
#undef PG8_LDB
#undef PG8_MMA
}
template <class F> struct EpiFn {
    F f;
    __device__ __forceinline__ void operator()(const f32x4 (&acc)[2][2][4][2], const Unit& u, int wr, int wc, int fr, int fq) const {
#pragma unroll
        for (int ai = 0; ai < 2; ++ai)
#pragma unroll
            for (int m = 0; m < 4; ++m)
#pragma unroll
                for (int bj = 0; bj < 2; ++bj)
#pragma unroll
                    for (int n = 0; n < 2; ++n) f(u.pm * BM + ai * HALF + wr * 64 + m * 16 + fr, u.pn * BM + bj * HALF + wc * 32 + n * 16 + 4 * fq, acc[ai][bj][m][n]);
    }
};
}
template <class F>
__device__ __forceinline__ void big_gemm_lat(const KP& p, unsigned char* smem, const bf16_t* A, const bf16_t* W, int N, F f) {
    pg8::Gemm g; g.A = A + (size_t)CTX * D; g.Bt = W; g.M = SEQ; g.N = N; g.K = D;
    pg8::StaticOrder S; S.init(SEQ, N, p.G, p.bid);
    auto f2 = [&](int r, int c, const f32x4& v) { f(r + CTX, c, v); };
    pg8::EpiFn<decltype(f2)> E{f2};
    pg8::gemm_phase((PG8_LAS unsigned char*)smem, p.tid, g, S, E);
}
template <class F>
__device__ __forceinline__ void ctx_gemm(const KP& p, unsigned char* smem, const bf16_t* A, const bf16_t* W, int N, int rot, F f) {
    const int tid = p.tid, lane = tid & 63, wid = tid >> 6, l15 = lane & 15, g = lane >> 4;
    float* red = (float*)smem;
    const int nitems = (CTX / 16) * (N / 64);
    for (int it = (p.bid + p.G - rot % p.G) % p.G; it < nitems; it += p.G) {
        const int m0 = (it % (CTX / 16)) * 16, n0 = (it / (CTX / 16)) * 64;
        const bf16_t* ap = A + (size_t)(m0 + l15) * D + wid * 128 + g * 8;
        const bf16_t* bp = W + (size_t)(n0 + l15) * D + wid * 128 + g * 8;
        bf16x8 af[4], bfr[4][4];
#pragma unroll
        for (int ks = 0; ks < 4; ++ks) {
            af[ks] = *(const bf16x8*)(ap + ks * 32);
#pragma unroll
            for (int nt = 0; nt < 4; ++nt) bfr[nt][ks] = *(const bf16x8*)(bp + (size_t)nt * 16 * D + ks * 32);
        }
        LDS_BARRIER();
#pragma unroll
        for (int nt = 0; nt < 4; ++nt) {
            f32x4 acc = {0.f, 0.f, 0.f, 0.f};
#pragma unroll
            for (int ks = 0; ks < 4; ++ks) acc = mfma16(bfr[nt][ks], af[ks], acc);
            *(float4*)(red + ((wid * 4 + nt) * 64 + lane) * 4) = make_float4(acc[0], acc[1], acc[2], acc[3]);
        }
        LDS_BARRIER();
        if (tid < 256) {
            const int nt = tid >> 6;
            float4 sum = *(const float4*)(red + (nt * 64 + lane) * 4);
#pragma unroll
            for (int w = 1; w < 8; ++w) { const float4 t = *(const float4*)(red + ((w * 4 + nt) * 64 + lane) * 4); sum.x += t.x; sum.y += t.y; sum.z += t.z; sum.w += t.w; }
            f(m0 + l15, n0 + nt * 16 + g * 4, (f32x4){sum.x, sum.y, sum.z, sum.w});
        }
    }
    LDS_BARRIER();
}
template <class F>
__device__ __forceinline__ void big_gemm(const KP& p, unsigned char* smem, const bf16_t* A, const bf16_t* W, int N, bool with_ctx, F f) {
    big_gemm_lat(p, smem, A, W, N, f);
    if (with_ctx) ctx_gemm(p, smem, A, W, N, 0, f);
}

template <int L = 0> __device__ __forceinline__ void row_ld(float* v, const float* p, int lane) {
    const float* q0 = L ? p + lane * 16 : p + lane * 8; const float* q1 = L ? p + lane * 16 + 8 : p + 512 + lane * 8;
    const float4 a = *(const float4*)q0, b = *(const float4*)(q0 + 4), c = *(const float4*)q1, d = *(const float4*)(q1 + 4);
    v[0] = a.x; v[1] = a.y; v[2] = a.z; v[3] = a.w; v[4] = b.x; v[5] = b.y; v[6] = b.z; v[7] = b.w;
    v[8] = c.x; v[9] = c.y; v[10] = c.z; v[11] = c.w; v[12] = d.x; v[13] = d.y; v[14] = d.z; v[15] = d.w;
}
template <int L = 0> __device__ __forceinline__ void row_st(float* p, const float* v, int lane) {
    float* q0 = L ? p + lane * 16 : p + lane * 8; float* q1 = L ? p + lane * 16 + 8 : p + 512 + lane * 8;
    *(float4*)q0 = make_float4(v[0], v[1], v[2], v[3]); *(float4*)(q0 + 4) = make_float4(v[4], v[5], v[6], v[7]);
    *(float4*)q1 = make_float4(v[8], v[9], v[10], v[11]); *(float4*)(q1 + 4) = make_float4(v[12], v[13], v[14], v[15]);
}
__device__ __forceinline__ void row_ld_bf(float* v, const bf16_t* p, int lane) {
    unpack8(*(const uint4*)(p + lane * 8), v); unpack8(*(const uint4*)(p + 512 + lane * 8), v + 8);
}
template <int L = 0> __device__ __forceinline__ void row_st_bf(bf16_t* p, const float* v, int lane) {
    *(uint4*)(L ? p + lane * 16 : p + lane * 8) = pack8(v); *(uint4*)(L ? p + lane * 16 + 8 : p + 512 + lane * 8) = pack8(v + 8);
}
template <int L = 0> __device__ __forceinline__ void row_layernorm(float* v, const float* g, const float* b, int lane) {
    float s = 0.f;
#pragma unroll
    for (int i = 0; i < 16; ++i) s += v[i];
    const float mu = wave_sum(s) * (1.f / 1024.f);
    float q = 0.f;
#pragma unroll
    for (int i = 0; i < 16; ++i) { const float d = v[i] - mu; q += d * d; }
    const float rs = rsqrtf(wave_sum(q) * (1.f / 1024.f) + 1e-5f);
    float gg[16], bb[16]; row_ld<L>(gg, g, lane); row_ld<L>(bb, b, lane);
#pragma unroll
    for (int i = 0; i < 16; ++i) v[i] = (v[i] - mu) * rs * gg[i] + bb[i];
}
__device__ __forceinline__ const float* modp(const KP& p, int layer, int tok, int part) {
    return (const float*)(p.ws + O_MOD) + ((size_t)(layer * 2 + (tok < CTX ? 1 : 0)) * 6 + part) * 1024;
}
template <int L = 0> __device__ __forceinline__ void emit_layer_input(const KP& p, int layer, int tok, const float* x, int lane) {
    if (layer >= DEPTH || (layer & 1)) return;
    float sh[16], sc[16], h[16];
    row_ld<L>(sh, modp(p, layer, tok, 0), lane); row_ld<L>(sc, modp(p, layer, tok, 1), lane);
#pragma unroll
    for (int i = 0; i < 16; ++i) h[i] = x[i] * (1.f + sc[i]) + sh[i];
    row_st_bf<L>((bf16_t*)(p.ws + O_HB) + (size_t)tok * D, h, lane);
}

__device__ __forceinline__ void cvt_transpose(const KP& p, const float* src, int K, int N, int ld_src, bf16_t* dst, int Kp, int Np, unsigned char* smem, int& base) {
    float* tile = (float*)smem;
    const int ntk = Kp / 64, ntn = Np / 64, nt = ntk * ntn, G = p.G, tid = p.tid;
    for (int t = ((int)p.bid - base % G + G) % G; t < nt; t += G) {
        const int k0 = (t / ntn) * 64, n0 = (t % ntn) * 64;
        { const int kl = tid >> 3, n8 = (tid & 7) * 8;
#pragma unroll
          for (int j = 0; j < 8; ++j) tile[kl * 65 + n8 + j] = 0.f;
          const int k = k0 + kl;
          if (k < K && n0 + n8 + 8 <= N && (ld_src & 3) == 0) {
              const float4 a = *(const float4*)(src + (size_t)k * ld_src + n0 + n8), b = *(const float4*)(src + (size_t)k * ld_src + n0 + n8 + 4);
              float* tp = tile + kl * 65 + n8; tp[0] = a.x; tp[1] = a.y; tp[2] = a.z; tp[3] = a.w; tp[4] = b.x; tp[5] = b.y; tp[6] = b.z; tp[7] = b.w;
          } else if (k < K) {
#pragma unroll
              for (int j = 0; j < 8; ++j) { const int n = n0 + n8 + j; if (n < N) tile[kl * 65 + n8 + j] = src[(size_t)k * ld_src + n]; }
          } }
        __syncthreads();
        { const int nl = tid >> 3, k8 = (tid & 7) * 8; float f[8];
#pragma unroll
          for (int j = 0; j < 8; ++j) f[j] = tile[(k8 + j) * 65 + nl];
          *(uint4*)(dst + (size_t)(n0 + nl) * Kp + k0 + k8) = pack8(f); }
        __syncthreads();
    }
    base += nt;
}
__device__ __forceinline__ void phase_setup(const Params& p_, unsigned char* smem) { const KP p = fresh(p_);
    const int G = p.G, bid = p.bid, tid = p.tid;
    unsigned char* ws = p.ws;
    int base = 0;
    for (int j = 0; j < NA; ++j) {
        cvt_transpose(p, p.in(8) + (size_t)j * 1024 * MPROJ, 1024, 4096, MPROJ, (bf16_t*)(ws + O_WIN) + (size_t)j * 4096 * 1024, 1024, 4096, smem, base);
        cvt_transpose(p, p.in(13) + (size_t)j * 1024 * 1024, 1024, 1024, 1024, (bf16_t*)(ws + O_WOUTM) + (size_t)j * 1024 * 1024, 1024, 1024, smem, base);
    }
    for (int j = 0; j < NB; ++j) {
        for (int n = 0; n < 3; ++n) cvt_transpose(p, p.in(15) + (size_t)(j * 3 + n) * 1024 * 1024, 1024, 1024, 1024, (bf16_t*)(ws + O_WRKV) + (size_t)(j * 3 + n) * 1024 * 1024, 1024, 1024, smem, base);
        for (int z = 0; z < 2; ++z) {
            cvt_transpose(p, p.in(17) + (size_t)(j * 2 + z) * 1024 * 64, 1024, 64, 64, (bf16_t*)(ws + O_W1C) + (size_t)(j * 128 + z * 64) * 1024, 1024, 64, smem, base);
            cvt_transpose(p, p.in(20) + (size_t)(j * 2 + z) * 1024 * 64, 1024, 64, 64, (bf16_t*)(ws + O_A1C) + (size_t)(j * 128 + z * 64) * 1024, 1024, 64, smem, base);
            cvt_transpose(p, p.in(18) + (size_t)(j * 2 + z) * 64 * 1024, 64, 1024, 1024, (bf16_t*)(ws + O_W2) + (size_t)(j * 2 + z) * 1024 * 64, 64, 1024, smem, base);
            cvt_transpose(p, p.in(21) + (size_t)(j * 2 + z) * 64 * 1024, 64, 1024, 1024, (bf16_t*)(ws + O_A2) + (size_t)(j * 2 + z) * 1024 * 64, 64, 1024, smem, base);
        }
        cvt_transpose(p, p.in(22) + (size_t)j * 1024 * 160, 1024, 160, 160, (bf16_t*)(ws + O_G1) + (size_t)j * 256 * 1024, 1024, 256, smem, base);
        cvt_transpose(p, p.in(23) + (size_t)j * 160 * 1024, 160, 1024, 1024, (bf16_t*)(ws + O_G2) + (size_t)j * 1024 * 192, 192, 1024, smem, base);
        cvt_transpose(p, p.in(29) + (size_t)j * 1024 * 1024, 1024, 1024, 1024, (bf16_t*)(ws + O_WOUTR) + (size_t)j * 1024 * 1024, 1024, 1024, smem, base);
    }
    for (int i = 0; i < DEPTH; ++i)
        cvt_transpose(p, p.in(30) + (size_t)i * 1024 * 2048, 1024, 2048, 2048, (bf16_t*)(ws + O_WQ) + (size_t)i * 2048 * 1024, 1024, 2048, smem, base);
    const size_t gtid = (size_t)bid * NT + tid, gstride = (size_t)G * NT;
    { const float* src = p.in(31); bf16_t* dst = (bf16_t*)(ws + O_KEYS);
      for (size_t i = gtid; i < (size_t)DEPTH * 16 * 128 * 128; i += gstride) dst[i] = f2bf(src[i]); }
    { float* dst = (float*)(ws + O_WING);
      for (size_t i = gtid; i < (size_t)NA * 16 * 1024; i += gstride) { const int k = i & 1023, g = (i >> 10) & 15, j = (int)(i >> 14); dst[i] = p.in(8)[((size_t)j * 1024 + k) * MPROJ + 4096 + g]; } }
    { bf16_t* dstb = (bf16_t*)(ws + O_WINGB);
      for (size_t i = gtid; i < (size_t)NA * 128 * 1024; i += gstride) { const int k = i & 1023, g = (i >> 10) & 127, j = (int)(i >> 17); dstb[i] = g < 16 ? f2bf(p.in(8)[((size_t)j * 1024 + k) * MPROJ + 4096 + g]) : (bf16_t)0; } }
    { bf16_t* dstc = (bf16_t*)(ws + O_CROW);
      for (size_t i = gtid; i < (size_t)DEPTH * 2048; i += gstride) { const int e = i & 1023, w = (i >> 10) & 1, l = (int)(i >> 11); dstc[((size_t)l * 4 + 2 + w) * 1024 + e] = f2bf((w ? p.in(7) : p.in(6))[(size_t)(l * 2 + 1) * D + e]); } }
    { float4* dst = (float4*)(ws + O_XS); const float4* c4 = (const float4*)p.in(2); const float4* x4 = (const float4*)p.in(0);
      for (size_t i = gtid; i < (size_t)T * 256; i += gstride) dst[i] = i < (size_t)CTX * 256 ? c4[i] : x4[i - (size_t)CTX * 256]; }
    { float* red = (float*)smem;
      float* ssil = red + 1024;
      for (int k = tid; k < 2048; k += NT) ssil[k] = siluf_(k < 1024 ? p.in(1)[k] : p.in(3)[k - 1024]);
      __syncthreads();
      const int lane = tid & 63, w = tid >> 6;
      for (int it = bid; it < DEPTH * 96; it += G) {
          const int layer = it / 96, col = (it % 96) * 64 + lane;
          const float* W = p.in(4) + (size_t)layer * 1024 * 6144;
          float a0 = 0.f, a1 = 0.f;
          for (int k = w * 128; k < w * 128 + 128; ++k) { const float wv = W[(size_t)k * 6144 + col]; a0 += ssil[k] * wv; a1 += ssil[1024 + k] * wv; }
          red[(w * 2 + 0) * 64 + lane] = a0; red[(w * 2 + 1) * 64 + lane] = a1;
          __syncthreads();
          if (tid < 128) { const int s = tid >> 6; float acc = 0.f;
#pragma unroll
              for (int ww = 0; ww < 8; ++ww) acc += red[(ww * 2 + s) * 64 + lane];
              const float mv_ = acc + p.in(5)[(size_t)layer * 6144 + col]; ((float*)(ws + O_MOD))[((size_t)layer * 2 + s) * 6144 + col] = mv_;
              if (col >= 5120) ((bf16_t*)(ws + O_CROW))[((size_t)layer * 4 + s) * 1024 + (col - 5120)] = f2bf(mv_); }
          __syncthreads();
      } }
}
__device__ __forceinline__ void phase_emit0(const Params& p_) { const KP p = fresh(p_);
    const int lane = p.tid & 63, gw = p.bid * 8 + (p.tid >> 6), nw = p.G * 8;
    for (int tok = gw; tok < T; tok += nw) { float x[16]; row_ld(x, (const float*)(p.ws + O_XS) + (size_t)tok * D, lane); emit_layer_input(p, 0, tok, x, lane); }
}
#if PEER_FP6
__device__ __forceinline__ void convert_peer_tables(const KP& p, int layer, int wg0 = 0, int nwg = 0) {
    if (nwg == 0) nwg = p.G;
    if (p.bid < wg0) return;
    const int lane = p.tid & 63, l31 = lane & 31, half = lane >> 5, gw = (p.bid - wg0) * 8 + (p.tid >> 6), nw = nwg * 8;
    for (int r2 = gw; r2 < 16384; r2 += nw) {
        const int r = r2 * 2 + half, which = r >> 14, row = r & 16383;
        const float* src = (which ? p.in(33) : p.in(32)) + ((size_t)layer * 16384 + row) * 1024 + l31 * 32;
        float v[32];
#pragma unroll
        for (int q = 0; q < 8; ++q) { const float4 a = *(const float4*)(src + q * 4); v[q * 4] = a.x; v[q * 4 + 1] = a.y; v[q * 4 + 2] = a.z; v[q * 4 + 3] = a.w; }
        float m = 0.f;
#pragma unroll
        for (int i = 0; i < 32; ++i) m = fmaxf(m, fabsf(v[i]));
#pragma unroll
        for (int o = 16; o >= 1; o >>= 1) m = fmaxf(m, __shfl_xor(m, o));
        const float sc = m > 0.f ? 7.f / m : 1.f;
#pragma unroll
        for (int i = 0; i < 32; ++i) v[i] *= sc;
        unsigned w[6]; fp6x32_pack(v, w);
        unsigned char* dst = p.ws + (which ? O_VT2 : O_UT) + (size_t)row * 768;
        *(uint4*)(dst + l31 * 16) = make_uint4(w[0], w[1], w[2], w[3]); *(uint2*)(dst + 512 + l31 * 8) = make_uint2(w[4], w[5]);
        if (l31 == 0) ((float*)(p.ws + (which ? O_VS : O_US)))[row] = 1.f / sc;
    }
}
#else
__device__ __forceinline__ void convert_peer_tables(const KP& p, int layer, int wg0 = 0, int nwg = 0) {
    if (nwg == 0) nwg = p.G;
    if (p.bid < wg0) return;
    const int lane = p.tid & 63, gw = (p.bid - wg0) * 8 + (p.tid >> 6), nw = nwg * 8;
    for (int r = gw; r < 2 * 16384; r += nw) {
        const int which = r >> 14, row = r & 16383;
        const float* src = (which ? p.in(33) : p.in(32)) + ((size_t)layer * 16384 + row) * 1024;
        float v[16]; row_ld<1>(v, src, lane);
        float m = 0.f;
#pragma unroll
        for (int i = 0; i < 16; ++i) m = fmaxf(m, fabsf(v[i]));
        m = wave_max(m);
        const float sc = m > 0.f ? 256.f / m : 1.f;
#pragma unroll
        for (int i = 0; i < 16; ++i) v[i] *= sc;
        *(uint4*)(p.ws + (which ? O_VT2 : O_UT) + (size_t)row * 1024 + lane * 16) = fp8x16_enc(v);
        if (lane == 0) ((float*)(p.ws + (which ? O_VS : O_US)))[row] = 1.f / sc;
    }
}

#endif

__device__ __forceinline__ void phase_ml_gates(const Params& p_, int j, unsigned char* smem) { const KP p = fresh(p_);
    unsigned char* ws = p.ws; const int G = p.G;
    const bf16_t* HB = (const bf16_t*)(ws + O_HB); const bf16_t* WB = (const bf16_t*)(ws + O_WINGB) + (size_t)j * 128 * 1024;
    const float* bin = p.in(9) + (size_t)j * MPROJ + 4096; float* GT = (float*)(ws + O_GATES);
    for (int t = p.bid; t < NCH; t += G) {
        f32x4 acc[4][2];
        gemm_core(p.tid, mkseg(HB + (size_t)t * 128 * D, D, WB, D, D), mkseg(HB, 0, HB, 0, 0), mkseg(HB, 0, HB, 0, 0), smem, acc);
        ACC_FOREACH({ if (n < 16) { const float4 b4 = *(const float4*)(bin + n); st_f4(GT + (size_t)(t * 128 + m) * 16 + n, v[0] + b4.x, v[1] + b4.y, v[2] + b4.z, v[3] + b4.w); } })
    }
}
__device__ __forceinline__ void phase_ml_inproj(const Params& p_, int j, unsigned char* smem) { const KP p = fresh(p_);
    unsigned char* ws = p.ws; const int G = p.G;
    const bf16_t* HB = (const bf16_t*)(ws + O_HB); const bf16_t* W = (const bf16_t*)(ws + O_WIN) + (size_t)j * 4096 * 1024;
    const float* bin = p.in(9) + (size_t)j * MPROJ;
    bf16_t* PQK = (bf16_t*)(ws + M_PQK); bf16_t* VB = (bf16_t*)(ws + M_VB); bf16_t* OB = (bf16_t*)(ws + M_OB);
    big_gemm(p, smem, HB, W, 4096, true, [&](int row_, int col, const f32x4& v) {
        const size_t row = (size_t)row_;
        const float4 b4 = *(const float4*)(bin + col);
        const float a = v[0] + b4.x, b = v[1] + b4.y, c = v[2] + b4.z, d = v[3] + b4.w;
        if (col < 2048) st_bf4(PQK + row * 2048 + col, a, b, c, d);
        else if (col < 3072) st_bf4(VB + row * D + (col - 2048), a, b, c, d);
        else st_bf4(OB + row * D + (col - 3072), sigmoidf_(a), sigmoidf_(b), sigmoidf_(c), sigmoidf_(d));
    });
    const int lane = p.tid & 63, gw = p.bid * 8 + (p.tid >> 6), nw = G * 8;
    const float* GT = (const float*)(ws + O_GATES);
    for (int u = gw; u < 8 * NCH; u += nw) {
        const int dh = u / NCH, c = u % NCH, d = dh >> 2, h = dh & 3;
        const int p0 = 2 * lane, p1 = 2 * lane + 1;
        const int t0 = c * 128 + (d ? 127 - p0 : p0), t1 = c * 128 + (d ? 127 - p1 : p1);
        const float i0 = GT[(size_t)t0 * 16 + d * 4 + h], i1 = GT[(size_t)t1 * 16 + d * 4 + h];
        const float f0 = GT[(size_t)t0 * 16 + 8 + d * 4 + h], f1 = GT[(size_t)t1 * 16 + 8 + d * 4 + h];
        const float l0 = fminf(f0, 0.f) - log1pf(expf(-fabsf(f0))), l1 = fminf(f1, 0.f) - log1pf(expf(-fabsf(f1)));
        float s = l0 + l1, incl = s;
#pragma unroll
        for (int o = 1; o < 64; o <<= 1) { const float y = __shfl_up(incl, o); if (lane >= o) incl += y; }
        const float b0 = incl - s + l0, b1 = incl;
        const float blast = __shfl(b1, 63);
        const float e0 = i0 - b0, e1 = fmaxf(i0 - b0, i1 - b1);
        float pm = e1;
#pragma unroll
        for (int o = 1; o < 64; o <<= 1) { const float y = __shfl_up(pm, o); if (lane >= o) pm = fmaxf(pm, y); }
        float pmprev = __shfl_up(pm, 1); if (lane == 0) pmprev = -INFINITY;
        const float pm0 = fmaxf(pmprev, e0), pm1 = pm;
        const float w0 = blast - b0 + i0, w1 = blast - b1 + i1;
        const float mloc = wave_max(fmaxf(w0, w1));
        const size_t o0 = (size_t)dh * T + t0, o1 = (size_t)dh * T + t1;
        ((float*)(ws + M_BCUM))[o0] = b0; ((float*)(ws + M_BCUM))[o1] = b1;
        ((float*)(ws + M_AS))[o0] = expf(w0 - mloc); ((float*)(ws + M_AS))[o1] = expf(w1 - mloc);
        ((float*)(ws + M_PMAX))[o0] = pm0; ((float*)(ws + M_PMAX))[o1] = pm1;
        if (lane == 0) { ((float*)(ws + M_MLOC))[u] = mloc; ((float*)(ws + M_BLAST))[u] = blast; }
    }
}
__device__ __forceinline__ void phase_ml_conv(const Params& p_, int j, unsigned char* smem) { const KP p = fresh(p_);
    unsigned char* ws = p.ws; const int G = p.G, tid = p.tid;
    const bf16_t* PQK = (const bf16_t*)(ws + M_PQK); const bf16_t* VB = (const bf16_t*)(ws + M_VB);
    bf16_t* QB = (bf16_t*)(ws + M_QB); bf16_t* KB = (bf16_t*)(ws + M_KB); bf16_t* KAT = (bf16_t*)(ws + M_KAT); bf16_t* VT = (bf16_t*)(ws + M_VT);
    const float* AS = (const float*)(ws + M_AS);
    const float* cw = p.in(10) + (size_t)j * 9 * 2048; const float* cb = p.in(11) + (size_t)j * 2048;
    float* tile = (float*)smem;
    const int tl = tid >> 3, c8 = (tid & 7) * 8;
    for (int it = p.bid; it < (T / 64) * 48; it += G) {
        const int tt = it / 48, kind = (it % 48) / 16, cbk = it % 16;
        const int tok = tt * 64 + tl;
        float o[8];
        if (kind < 2) {
            const int ch = kind * 1024 + cbk * 64 + c8;
            { const float4 b0 = *(const float4*)(cb + ch), b1 = *(const float4*)(cb + ch + 4); o[0] = b0.x; o[1] = b0.y; o[2] = b0.z; o[3] = b0.w; o[4] = b1.x; o[5] = b1.y; o[6] = b1.z; o[7] = b1.w; }
            const bool lat = tok >= CTX; const int s = tok - CTX, r = s >> 6, c = s & 63;
#pragma unroll
            for (int di = -1; di <= 1; ++di)
#pragma unroll
                for (int dj = -1; dj <= 1; ++dj) {
                    int nb = -1;
                    if (lat) { const int rr = r + di, cc = c + dj; if (rr >= 0 && rr < ROWS && cc >= 0 && cc < 64) nb = CTX + rr * 64 + cc; }
                    else if (di == 0) { const int tn = tok + dj; if (tn >= 0 && tn < CTX) nb = tn; }
                    if (nb >= 0) {
                        float x[8]; unpack8(*(const uint4*)(PQK + (size_t)nb * 2048 + ch), x);
                        const float* wp = cw + (size_t)((di + 1) * 3 + (dj + 1)) * 2048 + ch;
                        const float4 w0 = *(const float4*)wp, w1 = *(const float4*)(wp + 4);
                        o[0] += x[0] * w0.x; o[1] += x[1] * w0.y; o[2] += x[2] * w0.z; o[3] += x[3] * w0.w; o[4] += x[4] * w1.x; o[5] += x[5] * w1.y; o[6] += x[6] * w1.z; o[7] += x[7] * w1.w;
                    }
                }
#pragma unroll
            for (int i = 0; i < 8; ++i) o[i] = siluf_(o[i]) * (kind == 0 ? 0.0625f : 1.f);
            *(uint4*)((kind == 0 ? QB : KB) + (size_t)tok * D + cbk * 64 + c8) = pack8(o);
        } else {
            unpack8(*(const uint4*)(VB + (size_t)tok * D + cbk * 64 + c8), o);
        }
        if (kind >= 1) {
#pragma unroll
            for (int i = 0; i < 8; ++i) tile[tl * 65 + c8 + i] = o[i];
            __syncthreads();
            const int chl = tid >> 3, t8 = (tid & 7) * 8, chan = cbk * 64 + chl, h = chan >> 8;
            float f[8];
#pragma unroll
            for (int i = 0; i < 8; ++i) f[i] = tile[(t8 + i) * 65 + chl];
            if (kind == 2) *(uint4*)(VT + (size_t)chan * T + tt * 64 + t8) = pack8(f);
            else {
#pragma unroll
                for (int d = 0; d < 2; ++d) {
                    float g[8]; const float* ap = AS + (size_t)(d * 4 + h) * T + tt * 64 + t8;
#pragma unroll
                    for (int i = 0; i < 8; ++i) g[i] = f[i] * ap[i];
                    *(uint4*)(KAT + ((size_t)d * 1024 + chan) * T + tt * 64 + t8) = pack8(g);
                }
            }
            __syncthreads();
        }
    }
}
__device__ __forceinline__ void phase_ml_kvloc(const Params& p_, unsigned char* smem) { const KP p = fresh(p_);
    unsigned char* ws = p.ws; const int G = p.G;
    const bf16_t* KAT = (const bf16_t*)(ws + M_KAT); const bf16_t* VT = (const bf16_t*)(ws + M_VT); bf16_t* KV = (bf16_t*)(ws + M_KVLOC);
    for (int t = p.bid; t < 8 * NCH * 4; t += G) {
        const int u = t >> 2, mi = (t >> 1) & 1, ni = t & 1, dh = u / NCH, c = u % NCH, h = dh & 3;
        f32x4 acc[4][2];
        gemm_core(p.tid, mkseg(VT + (size_t)(h * 256 + mi * 128) * T + c * 128, T, KAT + (size_t)(dh * 256 + ni * 128) * T + c * 128, T, 128), mkseg(VT, 0, VT, 0, 0), mkseg(VT, 0, VT, 0, 0), smem, acc);
        bf16_t* out = KV + (size_t)u * 65536;
        ACC_FOREACH({ st_bf4(out + (size_t)(mi * 128 + m) * 256 + ni * 128 + n, v[0], v[1], v[2], v[3]); })
    }
    float* NLOC = (float*)(ws + M_NLOC);
    for (int it = p.bid * NT + p.tid; it < 8 * NCH * 256; it += G * NT) {
        const int u = it >> 8, dk = it & 255, dh = u / NCH, c = u % NCH;
        const uint4* kp = (const uint4*)(KAT + (size_t)(dh * 256 + dk) * T + c * 128);
        float sum = 0.f;
#pragma unroll
        for (int x = 0; x < 16; ++x) { float f[8]; unpack8(kp[x], f);
#pragma unroll
            for (int y = 0; y < 8; ++y) sum += f[y]; }
        NLOC[it] = sum;
    }
}
__device__ __forceinline__ int chunk_order(int d, int i) { return d == 0 ? i : (i < NCC ? NCC - 1 - i : NCH - 1 - (i - NCC)); }
__device__ __forceinline__ void phase_ml_scan(const Params& p_, int layer) { const KP p = fresh(p_);
    convert_peer_tables(p, layer);
    unsigned char* ws = p.ws;
    const bf16_t* KV = (const bf16_t*)(ws + M_KVLOC); bf16_t* CIN = (bf16_t*)(ws + M_CIN); const float* NLOC = (const float*)(ws + M_NLOC);
    const float* MLOC = (const float*)(ws + M_MLOC); const float* BLAST = (const float*)(ws + M_BLAST); float* MIN = (float*)(ws + M_MIN); float* NIN = (float*)(ws + M_NIN);
    const int gtid = p.bid * NT + p.tid, gstride = p.G * NT;
    constexpr int SB = 10;
    for (int it = gtid; it < 8 * 16384; it += gstride) {
        const int dh = it >> 14, e = (it & 16383) * 4, d = dh >> 2;
#ifdef CPU_EMU
        const bool hn = (it & ~63) < 2048;
#else
        const bool hn = (__builtin_amdgcn_readfirstlane(it) & ~63) < 2048;
#endif
        const int dh2 = (it >> 8) & 7, dk2 = it & 255, d2 = dh2 >> 2;
        float c0 = 0.f, c1 = 0.f, c2 = 0.f, c3 = 0.f, mst = -1e30f, nst = 0.f, mst2 = -1e30f;
        for (int i0 = 0; i0 < NCH; i0 += SB) {
            uint2 kv[SB]; float ml[SB], bl[SB], nl[SB], ml2[SB], bl2[SB];
#pragma unroll
            for (int q = 0; q < SB; ++q) { const int i = i0 + q < NCH ? i0 + q : NCH - 1, u = dh * NCH + chunk_order(d, i);
                kv[q] = *(const uint2*)(KV + (size_t)u * 65536 + e); ml[q] = MLOC[u]; bl[q] = BLAST[u]; nl[q] = 0.f; ml2[q] = 0.f; bl2[q] = 0.f; }
            if (hn) {
#pragma unroll
                for (int q = 0; q < SB; ++q) { const int i = i0 + q < NCH ? i0 + q : NCH - 1, u = dh2 * NCH + chunk_order(d2, i);
                    nl[q] = NLOC[(size_t)u * 256 + dk2]; ml2[q] = MLOC[u]; bl2[q] = BLAST[u]; }
            }
#pragma unroll
            for (int q = 0; q < SB; ++q) if (i0 + q < NCH) {
                const int u = dh * NCH + chunk_order(d, i0 + q);
                st_bf4(CIN + (size_t)u * 65536 + e, c0, c1, c2, c3);
                if (e == 0) MIN[u] = mst;
                const float mn = fmaxf(bl[q] + mst, ml[q]), gp = fexp(bl[q] + mst - mn), gl = fexp(ml[q] - mn);
                c0 = gp * c0 + gl * bflo(kv[q].x); c1 = gp * c1 + gl * bfhi(kv[q].x); c2 = gp * c2 + gl * bflo(kv[q].y); c3 = gp * c3 + gl * bfhi(kv[q].y);
                mst = mn;
            }
            if (hn) {
#pragma unroll
                for (int q = 0; q < SB; ++q) if (i0 + q < NCH) {
                    const int u = dh2 * NCH + chunk_order(d2, i0 + q);
                    NIN[(size_t)u * 256 + dk2] = nst;
                    const float mn = fmaxf(bl2[q] + mst2, ml2[q]), gp = fexp(bl2[q] + mst2 - mn), gl = fexp(ml2[q] - mn);
                    nst = gp * nst + gl * nl[q]; mst2 = mn;
                }
            }
        }
    }
}
__device__ __forceinline__ void ml_out_unit(const KP& p, int j, unsigned char* smem, const int h, const int c) {
    unsigned char* ws = p.ws; const int tid = p.tid, lane = tid & 63, wid = tid >> 6, wm = wid >> 2, wn = wid & 3;
    const bf16_t* PB = (const bf16_t*)(ws + M_PBUF); const bf16_t* VT = (const bf16_t*)(ws + M_VT); const bf16_t* QF = (const bf16_t*)(ws + M_QF); const bf16_t* QW = (const bf16_t*)(ws + M_QBW);
    const bf16_t* CIN = (const bf16_t*)(ws + M_CIN); const bf16_t* OB = (const bf16_t*)(ws + M_OB); bf16_t* HN = (bf16_t*)(ws + M_VB);
    const float* gw = p.in(12) + (size_t)j * D;
    float* spart = (float*)(smem + 36864);
    {
        f32x4 a0[4][2], a1[4][2];
        gemm_core(p.tid, mkseg(PB + (size_t)(h * NCH + c) * 16384, 128, VT + (size_t)(h * 256) * T + c * 128, T, 128),
                  mkseg(QF + (size_t)c * 128 * D + h * 256, D, CIN + (size_t)((0 * 4 + h) * NCH + c) * 65536, 256, 256),
                  mkseg(QW + (size_t)c * 128 * D + h * 256, D, CIN + (size_t)((1 * 4 + h) * NCH + c) * 65536, 256, 256), smem, a0);
        gemm_core(p.tid, mkseg(PB + (size_t)(h * NCH + c) * 16384, 128, VT + (size_t)(h * 256 + 128) * T + c * 128, T, 128),
                  mkseg(QF + (size_t)c * 128 * D + h * 256, D, CIN + (size_t)((0 * 4 + h) * NCH + c) * 65536 + (size_t)128 * 256, 256, 256),
                  mkseg(QW + (size_t)c * 128 * D + h * 256, D, CIN + (size_t)((1 * 4 + h) * NCH + c) * 65536 + (size_t)128 * 256, 256, 256), smem, a1);
        float mu[4], rs[4];
#pragma unroll
        for (int mt = 0; mt < 4; ++mt) {
            float s = 0.f;
#pragma unroll
            for (int nt = 0; nt < 2; ++nt)
#pragma unroll
                for (int i = 0; i < 4; ++i) s += a0[mt][nt][i] + a1[mt][nt][i];
            s += __shfl_xor(s, 16); s += __shfl_xor(s, 32);
            if ((lane >> 4) == 0) spart[wn * 128 + wm * 64 + mt * 16 + (lane & 15)] = s;
        }
        LDS_BARRIER();
#pragma unroll
        for (int mt = 0; mt < 4; ++mt) { const int m = wm * 64 + mt * 16 + (lane & 15); mu[mt] = ((spart[m] + spart[128 + m]) + (spart[256 + m] + spart[384 + m])) * (1.f / 256.f); }
        LDS_BARRIER();
#pragma unroll
        for (int mt = 0; mt < 4; ++mt) {
            float q = 0.f;
#pragma unroll
            for (int nt = 0; nt < 2; ++nt)
#pragma unroll
                for (int i = 0; i < 4; ++i) { const float d0 = a0[mt][nt][i] - mu[mt], d1 = a1[mt][nt][i] - mu[mt]; q += d0 * d0 + d1 * d1; }
            q += __shfl_xor(q, 16); q += __shfl_xor(q, 32);
            if ((lane >> 4) == 0) spart[wn * 128 + wm * 64 + mt * 16 + (lane & 15)] = q;
        }
        LDS_BARRIER();
#pragma unroll
        for (int mt = 0; mt < 4; ++mt) { const int m = wm * 64 + mt * 16 + (lane & 15); rs[mt] = rsqrtf(((spart[m] + spart[128 + m]) + (spart[256 + m] + spart[384 + m])) * (1.f / 256.f) + 1e-5f); }
#pragma unroll
        for (int mt = 0; mt < 4; ++mt)
#pragma unroll
            for (int nt = 0; nt < 2; ++nt)
#pragma unroll
                for (int t2 = 0; t2 < 2; ++t2) {
                    const int m = wm * 64 + mt * 16 + (lane & 15), n = wn * 32 + nt * 16 + (lane >> 4) * 4, col = h * 256 + t2 * 128 + n;
                    const size_t off = (size_t)(c * 128 + m) * D + col;
                    const uint2 ob = *(const uint2*)(OB + off); const float4 g = *(const float4*)(gw + col);
                    const f32x4 x = t2 ? a1[mt][nt] : a0[mt][nt];
                    st_bf4(HN + off, (x[0] - mu[mt]) * rs[mt] * bflo(ob.x) * g.x, (x[1] - mu[mt]) * rs[mt] * bfhi(ob.x) * g.y,
                           (x[2] - mu[mt]) * rs[mt] * bflo(ob.y) * g.z, (x[3] - mu[mt]) * rs[mt] * bfhi(ob.y) * g.w);
                }
    }
}
__device__ __forceinline__ void phase_ml_scores(const Params& p_, int j, unsigned char* smem) { const KP p = fresh(p_);
    unsigned char* ws = p.ws; const int G = p.G, tid = p.tid, lane = tid & 63;
    const bf16_t* QB = (const bf16_t*)(ws + M_QB); const bf16_t* KB = (const bf16_t*)(ws + M_KB);
    bf16_t* PB = (bf16_t*)(ws + M_PBUF); bf16_t* QF = (bf16_t*)(ws + M_QF); bf16_t* QW = (bf16_t*)(ws + M_QBW);
    const float* BC = (const float*)(ws + M_BCUM); const float* PM = (const float*)(ws + M_PMAX); const float* GT = (const float*)(ws + O_GATES);
    const float* MIN = (const float*)(ws + M_MIN); const float* NIN = (const float*)(ws + M_NIN);
    float* sb = (float*)smem;
    float* sg = sb + 256;
    float* smt = sg + 256;
    float* srow = smt + 256;
    float* sqn = srow + 256;
    float* sdec = sqn + 256;
    float* spart = sdec + 256;
    for (int t = p.bid; t < 4 * NCH; t += G) {
        const int h = t / NCH, c = t % NCH;
        f32x4 acc[4][2];
        gemm_core(p.tid, mkseg(QB + (size_t)c * 128 * D + h * 256, D, KB + (size_t)c * 128 * D + h * 256, D, 256), mkseg(QB, 0, QB, 0, 0), mkseg(QB, 0, QB, 0, 0), smem, acc);
        if (tid < 256) {
            const int d = tid >> 7, tl = tid & 127, tok = c * 128 + tl; const size_t idx = (size_t)(d * 4 + h) * T + tok;
            const float b = BC[idx], mi = MIN[(d * 4 + h) * NCH + c], mt = fmaxf(b + mi, b + PM[idx]);
            sb[tid] = b; sg[tid] = GT[(size_t)tok * 16 + d * 4 + h]; smt[tid] = mt; sdec[tid] = expf(b + mi - mt);
        }
        __syncthreads();
        {
            const int pr = tid >> 1, half = tid & 1, d = pr >> 7, tl = pr & 127;
            const bf16_t* qp = QB + (size_t)(c * 128 + tl) * D + h * 256 + half * 128; const float* np_ = NIN + (size_t)((d * 4 + h) * NCH + c) * 256 + half * 128;
            float s = 0.f;
            for (int x = 0; x < 16; ++x) { float f[8]; unpack8(*(const uint4*)(qp + x * 8), f);
#pragma unroll
                for (int y = 0; y < 8; ++y) s += f[y] * np_[x * 8 + y]; }
            s += __shfl_xor(s, 1);
            if (half == 0) sqn[pr] = s;
        }
        float pf[4][2][4], pb[4][2][4];
        {
            const int wid = tid >> 6, wm = wid >> 2, wn = wid & 3;
#pragma unroll
            for (int mt = 0; mt < 4; ++mt) {
                const int m = wm * 64 + mt * 16 + (lane & 15);
                const float bf_ = sb[m], bb_ = sb[128 + m], mf = smt[m], mb = smt[128 + m];
                float rf = 0.f, rb = 0.f;
#pragma unroll
                for (int nt = 0; nt < 2; ++nt) {
                    const int n = wn * 32 + nt * 16 + (lane >> 4) * 4;
#pragma unroll
                    for (int i = 0; i < 4; ++i) {
                        const int s = n + i; const float sv = acc[mt][nt][i];
                        const float vf = (s <= m) ? sv * fexp(bf_ - sb[s] + sg[s] - mf) : 0.f;
                        const float vb = (s >= m) ? sv * fexp(bb_ - sb[128 + s] + sg[128 + s] - mb) : 0.f;
                        pf[mt][nt][i] = vf; pb[mt][nt][i] = vb; rf += vf; rb += vb;
                    }
                }
                rf += __shfl_xor(rf, 16); rf += __shfl_xor(rf, 32); rb += __shfl_xor(rb, 16); rb += __shfl_xor(rb, 32);
                if ((lane >> 4) == 0) { spart[wn * 256 + m] = rf; spart[wn * 256 + 128 + m] = rb; }
            }
        }
        __syncthreads();
        if (tid < 256) {
            const float den = ((spart[tid] + spart[256 + tid]) + (spart[512 + tid] + spart[768 + tid])) + sdec[tid] * sqn[tid];
            const float r = 1.f / fmaxf(fabsf(den), expf(-smt[tid]));
            srow[tid] = r; sqn[tid] = sdec[tid] * r;
        }
        __syncthreads();
        {
            const int wid = tid >> 6, wm = wid >> 2, wn = wid & 3;
            bf16_t* out = PB + (size_t)(h * NCH + c) * 16384;
#pragma unroll
            for (int mt = 0; mt < 4; ++mt) {
                const int m = wm * 64 + mt * 16 + (lane & 15); const float rf = srow[m], rb = srow[128 + m];
#pragma unroll
                for (int nt = 0; nt < 2; ++nt) {
                    const int n = wn * 32 + nt * 16 + (lane >> 4) * 4;
                    st_bf4(out + m * 128 + n, pf[mt][nt][0] * rf + pb[mt][nt][0] * rb, pf[mt][nt][1] * rf + pb[mt][nt][1] * rb,
                           pf[mt][nt][2] * rf + pb[mt][nt][2] * rb, pf[mt][nt][3] * rf + pb[mt][nt][3] * rb);
                }
            }
            for (int g = tid; g < 4096; g += NT) {
                const int tl = g >> 5, c8 = (g & 31) * 8; const size_t off = (size_t)(c * 128 + tl) * D + h * 256 + c8;
                float f[8], o[8]; unpack8(*(const uint4*)(QB + off), f);
                const float s0 = sqn[tl], s1 = sqn[128 + tl];
#pragma unroll
                for (int i = 0; i < 8; ++i) o[i] = f[i] * s0;
                *(uint4*)(QF + off) = pack8(o);
#pragma unroll
                for (int i = 0; i < 8; ++i) o[i] = f[i] * s1;
                *(uint4*)(QW + off) = pack8(o);
            }
        }
        __syncthreads();
        ml_out_unit(p, j, smem, h, c);
        __syncthreads();
    }
}
__device__ __forceinline__ void phase_ml_headnorm(const Params& p_, int j) { const KP p = fresh(p_);
    unsigned char* ws = p.ws; const int lane = p.tid & 63, gw = p.bid * 8 + (p.tid >> 6), nw = p.G * 8;
    const float* HOUT = (const float*)(ws + M_PQK); const bf16_t* OB = (const bf16_t*)(ws + M_OB); bf16_t* HN = (bf16_t*)(ws + M_VB);
    float g[16]; row_ld(g, p.in(12) + (size_t)j * D, lane);
    for (int tok = gw; tok < T; tok += nw) {
        float v[16], o[16]; row_ld(v, HOUT + (size_t)tok * D, lane); row_ld_bf(o, OB + (size_t)tok * D, lane);
        float s0 = 0.f, s1 = 0.f;
#pragma unroll
        for (int i = 0; i < 8; ++i) { s0 += v[i]; s1 += v[8 + i]; }
#pragma unroll
        for (int m = 16; m >= 1; m >>= 1) { s0 += __shfl_xor(s0, m); s1 += __shfl_xor(s1, m); }
        const float mu0 = s0 * (1.f / 256.f), mu1 = s1 * (1.f / 256.f);
        float q0 = 0.f, q1 = 0.f;
#pragma unroll
        for (int i = 0; i < 8; ++i) { const float a = v[i] - mu0, b = v[8 + i] - mu1; q0 += a * a; q1 += b * b; }
#pragma unroll
        for (int m = 16; m >= 1; m >>= 1) { q0 += __shfl_xor(q0, m); q1 += __shfl_xor(q1, m); }
        const float r0 = rsqrtf(q0 * (1.f / 256.f) + 1e-5f), r1 = rsqrtf(q1 * (1.f / 256.f) + 1e-5f);
#pragma unroll
        for (int i = 0; i < 8; ++i) { v[i] = (v[i] - mu0) * r0 * o[i] * g[i]; v[8 + i] = (v[8 + i] - mu1) * r1 * o[8 + i] * g[8 + i]; }
        row_st_bf(HN + (size_t)tok * D, v, lane);
    }
}
__device__ __forceinline__ void phase_proj_out(const Params& p_, size_t offA, size_t offW, size_t offY, unsigned char* smem) { const KP p = fresh(p_);
    const bf16_t* A = (const bf16_t*)(p.ws + offA); const bf16_t* W = (const bf16_t*)(p.ws + offW); bf16_t* Y = (bf16_t*)(p.ws + offY);
    big_gemm(p, smem, A, W, 1024, true, [&](int row, int col, const f32x4& v) { st_bf4(Y + (size_t)row * D + col, v[0], v[1], v[2], v[3]); });
}
__device__ __forceinline__ void phase_ln_mid(const Params& p_, int layer, size_t offY) { const KP p = fresh(p_);
    const bf16_t* Y = (const bf16_t*)(p.ws + offY);
    unsigned char* ws = p.ws; const int lane = p.tid & 63, gw = p.bid * 8 + (p.tid >> 6), nw = p.G * 8;
    float* XS = (float*)(ws + O_XS); bf16_t* HB = (bf16_t*)(ws + O_HB);
    const float* lg = p.in(6) + (size_t)(layer * 2 + 0) * D; const float* lb = p.in(7) + (size_t)(layer * 2 + 0) * D;
    const int t_begin = (layer == DEPTH - 1) ? CTX : 0;
    float g[16], sh[16], sc[16], gg[16], bb[16]; int cls = -1;
    row_ld(gg, lg, lane); row_ld(bb, lb, lane);
    for (int tok = t_begin + gw; tok < T; tok += nw) {
        const int c_ = tok < CTX ? 1 : 0;
        if (c_ != cls) { cls = c_; row_ld(g, modp(p, layer, tok, 2), lane); row_ld(sh, modp(p, layer, tok, 3), lane); row_ld(sc, modp(p, layer, tok, 4), lane); }
        float x[16], y[16]; row_ld(x, XS + (size_t)tok * D, lane); row_ld_bf(y, Y + (size_t)tok * D, lane);
#pragma unroll
        for (int i = 0; i < 16; ++i) x[i] = DN_ALPHA * x[i] + g[i] * y[i];
        {
            float s = 0.f;
#pragma unroll
            for (int i = 0; i < 16; ++i) s += x[i];
            const float mu = wave_sum(s) * (1.f / 1024.f);
            float q = 0.f;
#pragma unroll
            for (int i = 0; i < 16; ++i) { const float d = x[i] - mu; q += d * d; }
            const float rs = rsqrtf(wave_sum(q) * (1.f / 1024.f) + 1e-5f);
#pragma unroll
            for (int i = 0; i < 16; ++i) x[i] = (x[i] - mu) * rs * gg[i] + bb[i];
        }
        row_st(XS + (size_t)tok * D, x, lane);
#pragma unroll
        for (int i = 0; i < 16; ++i) y[i] = x[i] * (1.f + sc[i]) + sh[i];
        row_st_bf(HB + (size_t)tok * D, y, lane);
    }
}

__device__ __forceinline__ void phase_rw_mix(const Params& p_, int layer) { const KP p = fresh(p_);
    unsigned char* ws = p.ws; const int lane = p.tid & 63, gw = p.bid * 8 + (p.tid >> 6), nw = p.G * 8, j = layer >> 1;
    const float* XS = (const float*)(ws + O_XS); bf16_t* XM = (bf16_t*)(ws + R_XM);
    const float* mu = p.in(14) + (size_t)j * 6 * D;
    float mrow[6][16], sh[16], sc[16]; int cls = -1;
#pragma unroll
    for (int n = 0; n < 6; ++n) row_ld(mrow[n], mu + (size_t)n * D, lane);
    for (int tok = gw; tok < T; tok += nw) {
        float h[16], nbv[16];
        { const int c_ = tok < CTX ? 1 : 0; if (c_ != cls) { cls = c_; row_ld(sh, modp(p, layer, tok, 0), lane); row_ld(sc, modp(p, layer, tok, 1), lane); } }
        row_ld(h, XS + (size_t)tok * D, lane);
#pragma unroll
        for (int i = 0; i < 16; ++i) h[i] = h[i] * (1.f + sc[i]) + sh[i];
        int na, nb;
        if (tok >= CTX) {
            const int s = tok - CTX, r = s >> 6, c = s & 63;
            if (lane < 32) { na = c > 0 ? tok - 1 : -1; nb = r > 0 ? tok - 64 : -1; }
            else { na = c < 63 ? tok + 1 : -1; nb = r < ROWS - 1 ? tok + 64 : -1; }
        } else { na = tok > 0 ? tok - 1 : -1; nb = tok < CTX - 1 ? tok + 1 : -1; }
        {
            float4 a = make_float4(0.f, 0.f, 0.f, 0.f), b = a, c = a, d = a;
            if (na >= 0) { const float* q = XS + (size_t)na * D + lane * 8; a = *(const float4*)q; b = *(const float4*)(q + 4); }
            if (nb >= 0) { const float* q = XS + (size_t)nb * D + 512 + lane * 8; c = *(const float4*)q; d = *(const float4*)(q + 4); }
            nbv[0] = a.x; nbv[1] = a.y; nbv[2] = a.z; nbv[3] = a.w; nbv[4] = b.x; nbv[5] = b.y; nbv[6] = b.z; nbv[7] = b.w;
            nbv[8] = c.x; nbv[9] = c.y; nbv[10] = c.z; nbv[11] = c.w; nbv[12] = d.x; nbv[13] = d.y; nbv[14] = d.z; nbv[15] = d.w;
        }
#pragma unroll
        for (int i = 0; i < 8; ++i) { nbv[i] = na >= 0 ? nbv[i] * (1.f + sc[i]) + sh[i] : 0.f; nbv[8 + i] = nb >= 0 ? nbv[8 + i] * (1.f + sc[8 + i]) + sh[8 + i] : 0.f; }
#pragma unroll
        for (int n = 0; n < 6; ++n) {
            float o[16];
#pragma unroll
            for (int i = 0; i < 16; ++i) o[i] = h[i] + (nbv[i] - h[i]) * mrow[n][i];
            row_st_bf(XM + ((size_t)n * T + tok) * D, o, lane);
        }
    }
}
__device__ __forceinline__ void phase_rw_proj1(const Params& p_, int j, unsigned char* smem) { const KP p = fresh(p_);
    unsigned char* ws = p.ws; const int G = p.G;
    const bf16_t* XM = (const bf16_t*)(ws + R_XM);
    for (int job = 0; job < 3; ++job) {
        bf16_t* O = (bf16_t*)(ws + (job == 0 ? R_RB : job == 1 ? R_KB : R_VB));
        big_gemm_lat(p, smem, XM + (size_t)job * T * D, (const bf16_t*)(ws + O_WRKV) + (size_t)(j * 3 + job) * 1024 * 1024, 1024,
                     [&](int row, int col, const f32x4& v) { st_bf4(O + (size_t)row * D + col, v[0], v[1], v[2], v[3]); });
    }
    for (int job = 0; job < 3; ++job) {
        bf16_t* O = (bf16_t*)(ws + (job == 0 ? R_RB : job == 1 ? R_KB : R_VB));
        ctx_gemm(p, smem, XM + (size_t)job * T * D, (const bf16_t*)(ws + O_WRKV) + (size_t)(j * 3 + job) * 1024 * 1024, 1024, 0,
                 [&](int row, int col, const f32x4& v) { st_bf4(O + (size_t)row * D + col, v[0], v[1], v[2], v[3]); });
    }
    for (int t = p.bid; t < NCH * 4; t += G) {
        int job, n0; const int q = t & 3, m0 = (t >> 2) * 128;
        if (q == 0) { job = 3; n0 = 0; } else if (q == 1) { job = 4; n0 = 0; } else { job = 5; n0 = (q - 2) * 128; }
        const bf16_t* A = XM + ((size_t)job * T + m0) * D;
        const bf16_t* W = job == 3 ? (const bf16_t*)(ws + O_W1C) + (size_t)j * 128 * 1024 : job == 4 ? (const bf16_t*)(ws + O_A1C) + (size_t)j * 128 * 1024 : (const bf16_t*)(ws + O_G1) + (size_t)j * 256 * 1024;
        f32x4 acc[4][2];
        gemm_core(p.tid, mkseg(A, D, W + (size_t)n0 * D, D, D), mkseg(A, 0, W, 0, 0), mkseg(A, 0, W, 0, 0), smem, acc);
        if (job == 3) { bf16_t* O = (bf16_t*)(ws + R_LW1); ACC_FOREACH({ st_bf4(O + (size_t)(m0 + m) * 128 + n, ftanh(v[0]), ftanh(v[1]), ftanh(v[2]), ftanh(v[3])); }) }
        else if (job == 4) { bf16_t* O = (bf16_t*)(ws + R_LA1); ACC_FOREACH({ st_bf4(O + (size_t)(m0 + m) * 128 + n, v[0], v[1], v[2], v[3]); }) }
        else { bf16_t* O = (bf16_t*)(ws + R_LG1);
            ACC_FOREACH({ const int col = n0 + n; if (col < 192) { const bool ok = col < 160; st_bf4(O + (size_t)(m0 + m) * 192 + col, ok ? sigmoidf_(v[0]) : 0.f, ok ? sigmoidf_(v[1]) : 0.f, ok ? sigmoidf_(v[2]) : 0.f, ok ? sigmoidf_(v[3]) : 0.f); } }) }
    }
}
__device__ __forceinline__ void phase_rw_proj2(const Params& p_, int j, unsigned char* smem) { const KP p = fresh(p_);
    unsigned char* ws = p.ws; const int G = p.G;
    for (int t = p.bid; t < NCH * 40; t += G) {
        const int m0 = (t / 40) * 128, q = t % 40, job = q >> 3, n0 = (q & 7) * 128;
        f32x4 acc[4][2];
        if (job < 2) {
            const bf16_t* A = (const bf16_t*)(ws + R_LW1) + (size_t)m0 * 128 + job * 64; const bf16_t* W = (const bf16_t*)(ws + O_W2) + (size_t)(j * 2 + job) * 1024 * 64 + (size_t)n0 * 64;
            gemm_core(p.tid, mkseg(A, 128, W, 64, 64), mkseg(A, 0, W, 0, 0), mkseg(A, 0, W, 0, 0), smem, acc);
            const float* w0 = p.in(16) + (size_t)(j * 2 + job) * D; bf16_t* O = (bf16_t*)(ws + R_WDEC) + (size_t)job * T * D;
            ACC_FOREACH({ const float4 b = *(const float4*)(w0 + n0 + n);
                st_bf4(O + (size_t)(m0 + m) * D + n0 + n, -0.6065306597f * sigmoidf_(b.x + v[0]), -0.6065306597f * sigmoidf_(b.y + v[1]),
                       -0.6065306597f * sigmoidf_(b.z + v[2]), -0.6065306597f * sigmoidf_(b.w + v[3])); })
        } else if (job < 4) {
            const int z = job - 2;
            const bf16_t* A = (const bf16_t*)(ws + R_LA1) + (size_t)m0 * 128 + z * 64; const bf16_t* W = (const bf16_t*)(ws + O_A2) + (size_t)(j * 2 + z) * 1024 * 64 + (size_t)n0 * 64;
            gemm_core(p.tid, mkseg(A, 128, W, 64, 64), mkseg(A, 0, W, 0, 0), mkseg(A, 0, W, 0, 0), smem, acc);
            const float* a0 = p.in(19) + (size_t)(j * 2 + z) * D; bf16_t* O = (bf16_t*)(ws + R_AA) + (size_t)z * T * D;
            ACC_FOREACH({ const float4 b = *(const float4*)(a0 + n0 + n);
                st_bf4(O + (size_t)(m0 + m) * D + n0 + n, sigmoidf_(b.x + v[0]), sigmoidf_(b.y + v[1]), sigmoidf_(b.z + v[2]), sigmoidf_(b.w + v[3])); })
        } else {
            const bf16_t* A = (const bf16_t*)(ws + R_LG1) + (size_t)m0 * 192; const bf16_t* W = (const bf16_t*)(ws + O_G2) + (size_t)j * 1024 * 192 + (size_t)n0 * 192;
            gemm_core(p.tid, mkseg(A, 192, W, 192, 192), mkseg(A, 0, W, 0, 0), mkseg(A, 0, W, 0, 0), smem, acc);
            bf16_t* O = (bf16_t*)(ws + R_GG);
            ACC_FOREACH({ st_bf4(O + (size_t)(m0 + m) * D + n0 + n, v[0], v[1], v[2], v[3]); })
        }
    }
}
__device__ __forceinline__ float row16_sum(float v) {
#ifdef CPU_EMU
    v += __shfl_xor(v, 1); v += __shfl_xor(v, 2); v += __shfl_xor(v, 4); v += __shfl_xor(v, 8); return v;
#else
    v += __int_as_float(__builtin_amdgcn_update_dpp(0, __float_as_int(v), 0xB1, 0xF, 0xF, true));
    v += __int_as_float(__builtin_amdgcn_update_dpp(0, __float_as_int(v), 0x4E, 0xF, 0xF, true));
    v += __int_as_float(__builtin_amdgcn_update_dpp(0, __float_as_int(v), 0x141, 0xF, 0xF, true));
    v += __int_as_float(__builtin_amdgcn_update_dpp(0, __float_as_int(v), 0x140, 0xF, 0xF, true));
    return v;
#endif
}
#ifdef CPU_EMU
#define WAVE_SYNC() emu_wavesync()
#else
#define WAVE_SYNC() __builtin_amdgcn_wave_barrier()
#endif
__device__ __forceinline__ int rc_tok(int d, int ci, int t) {
    if (d == 0) return ci * 64 + t;
    return (ci * 64 < CTX ? CTX - 1 - ci * 64 : T - 1 - (ci * 64 - CTX)) - t;
}
__device__ __forceinline__ f32x4 mma_tile(const bf16_t* A, const bf16_t* B, f32x4 acc, int lane) {
#pragma unroll
    for (int ks = 0; ks < 64; ks += 32) {
        const bf16x8 a = *(const bf16x8*)(A + (lane & 15) * LSTR + ks + (lane >> 4) * 8);
        const bf16x8 b = *(const bf16x8*)(B + (lane & 15) * LSTR + ks + (lane >> 4) * 8);
        acc = mfma16(b, a, acc);
    }
    return acc;
}
__device__ __forceinline__ int swz_off(int row, int c) { return row * LSTR + ((((c >> 3) ^ (row >> 3)) & 7) << 3) + (c & 7); }
template <bool SA, bool SB>
__device__ __forceinline__ f32x4 mma_tile_s(const bf16_t* Am, int a0, const bf16_t* Bm, int b0, f32x4 acc, int lane) {
    const int ra = a0 + (lane & 15), rb = b0 + (lane & 15);
#pragma unroll
    for (int ks = 0; ks < 64; ks += 32) {
        const int c = ks + (lane >> 4) * 8;
        const bf16x8 a = *(const bf16x8*)(Am + (SA ? swz_off(ra, c) : ra * LSTR + c));
        const bf16x8 b = *(const bf16x8*)(Bm + (SB ? swz_off(rb, c) : rb * LSTR + c));
        acc = mfma16(b, a, acc);
    }
    return acc;
}
__device__ __forceinline__ float quad_sum(float v) {
#ifdef CPU_EMU
    v += __shfl_xor(v, 1); v += __shfl_xor(v, 2); return v;
#else
    v += __int_as_float(__builtin_amdgcn_update_dpp(0, __float_as_int(v), 0xB1, 0xF, 0xF, true));
    v += __int_as_float(__builtin_amdgcn_update_dpp(0, __float_as_int(v), 0x4E, 0xF, 0xF, true));
    return v;
#endif
}
__device__ __forceinline__ float oct_sum(float v) {
    v = quad_sum(v);
#ifdef CPU_EMU
    v += __shfl_xor(v, 4); return v;
#else
    v += __int_as_float(__builtin_amdgcn_update_dpp(0, __float_as_int(v), 0x141, 0xF, 0xF, true));
    return v;
#endif
}
constexpr int L_AR = 0, L_BK = 18432, L_VT = 36864, L_BHT = 46080, L_KHT = 55296, L_LAM = 64512, L_AAK = 80896, L_ARB = 90112, L_ARK = 99328,
              L_RHS = 108544, L_XT = 125952, L_GL = 144384, L_BS = 144640;
#define RC_LOAD(U) { const int _u = (U) < 32 * NC64 ? (U) : 32 * NC64 - 1; const int _dh = _u / NC64, _ci = _u % NC64, _d = _dh >> 4, _h = _dh & 15; \
    const size_t _o = (size_t)rc_tok(_d, _ci, st) * D + _h * 64 + sc8; \
    pf_r = *(const uint4*)((const bf16_t*)(ws + R_RB) + _o); pf_k = *(const uint4*)((const bf16_t*)(ws + R_KB) + _o); pf_v = *(const uint4*)((const bf16_t*)(ws + R_VB) + _o); \
    pf_a = *(const uint4*)((const bf16_t*)(ws + R_AA) + (size_t)_d * T * D + _o); pf_lw = *(const uint4*)((const bf16_t*)(ws + R_WDEC) + (size_t)_d * T * D + _o); }
__device__ __forceinline__ void phase_rw_chunk(const Params& p_, int j) { const KP p = fresh(p_);
    unsigned char* ws = p.ws; unsigned char* sm = p.sm; const int tid = p.tid, lane = tid & 63, wid = tid >> 6, G = p.G;
    bf16_t* sAR = (bf16_t*)(sm + L_AR); bf16_t* sBK = (bf16_t*)(sm + L_BK); bf16_t* sVT = (bf16_t*)(sm + L_VT); bf16_t* sBHT = (bf16_t*)(sm + L_BHT); bf16_t* sKHT = (bf16_t*)(sm + L_KHT);
    float* sLAM = (float*)(sm + L_LAM); bf16_t* sAAK = (bf16_t*)(sm + L_AAK); bf16_t* sARB = (bf16_t*)(sm + L_ARB); bf16_t* sARK = (bf16_t*)(sm + L_ARK);
    float* sRHSA = (float*)(sm + L_RHS); float* sRHSB = (float*)(sm + L_BK);   bf16_t* sXT = (bf16_t*)(sm + L_XT); float* sGL = (float*)(sm + L_GL); float* sBS = (float*)(sm + L_BS);
    const int st = tid >> 3, sc8 = (tid & 7) * 8;
    uint4 pf_r, pf_k, pf_v, pf_a, pf_lw;
    RC_LOAD(p.bid)
    for (int u = p.bid; u < 32 * NC64; u += G) {
        const int dh = u / NC64, ci = u % NC64, d = dh >> 4, h = dh & 15;
        float r8[8], kt8[8], v8[8], kk8[8], kka8[8], lw8[8];
        {
            const int col = h * 64 + sc8;
            float k8[8], a8[8];
            unpack8(pf_r, r8); unpack8(pf_k, k8); unpack8(pf_v, v8); unpack8(pf_a, a8);
            unpack8(pf_lw, lw8);
            RC_LOAD(u + G)
            const float* kkw = p.in(24) + (size_t)j * D + col; const float* ka = p.in(25) + (size_t)j * D + col;
            float nrm = 0.f;
#pragma unroll
            for (int i = 0; i < 8; ++i) { kk8[i] = k8[i] * kkw[i]; nrm += kk8[i] * kk8[i]; }
            nrm = oct_sum(nrm);
            const float rn = 1.f / fmaxf(sqrtf(nrm), 1e-12f);
#pragma unroll
            for (int i = 0; i < 8; ++i) { kk8[i] *= rn; kka8[i] = kk8[i] * a8[i]; kt8[i] = k8[i] * (1.f + (a8[i] - 1.f) * ka[i]); }
        }
        float L8[8], Lp8[8], LL8[8];
        {
            const int tl = lane >> 3;
#pragma unroll
            for (int i = 0; i < 8; ++i) {
                float x = lw8[i], y;
                y = __shfl_up(x, 8); if (tl >= 1) x += y;
                y = __shfl_up(x, 16); if (tl >= 2) x += y;
                y = __shfl_up(x, 32); if (tl >= 4) x += y;
                L8[i] = x;
                if (tl == 7) sBS[wid * 64 + sc8 + i] = x;
            }
            LDS_BARRIER();
            if (wid == 0) { float run = 0.f;
#pragma unroll
                for (int w2 = 0; w2 < 8; ++w2) { const float t = sBS[w2 * 64 + lane]; sBS[w2 * 64 + lane] = run; run += t; }
                sBS[512 + lane] = run; }
            LDS_BARRIER();
#pragma unroll
            for (int i = 0; i < 8; ++i) {
                const float off = sBS[wid * 64 + sc8 + i];
                L8[i] += off; LL8[i] = sBS[512 + sc8 + i];
                const float y = __shfl_up(L8[i], 8); Lp8[i] = tl > 0 ? y : off;
            }
        }
        {
            float fa[8], fr[8], fb[8], fk[8];
#pragma unroll
            for (int i = 0; i < 8; ++i) {
                const int ch = sc8 + i; const float L = L8[i], Lp = Lp8[i], LL = LL8[i];
                const float eL = fexp(L), emL = fexp(-L), eLp = fexp(Lp), eLL = fexp(LL - L);
                fa[i] = -kk8[i] * eLp; fr[i] = r8[i] * eL; fb[i] = kka8[i] * emL; fk[i] = kt8[i] * emL;
                const int so = swz_off(ch, st);
                sBHT[so] = f2bf(kka8[i] * eLL); sKHT[so] = f2bf(kt8[i] * eLL); sVT[so] = f2bf(v8[i]);
                if (st == 63) sGL[ch] = fexp(LL);
            }
            { const uint4 pa = pack8(fa); *(uint4*)(sAR + st * LSTR + sc8) = pa; float fb2[8]; unpack8(pa, fb2);
              *(float4*)(sRHSA + st * 68 + sc8) = make_float4(fb2[0], fb2[1], fb2[2], fb2[3]); *(float4*)(sRHSA + st * 68 + sc8 + 4) = make_float4(fb2[4], fb2[5], fb2[6], fb2[7]); }
            *(uint4*)(sAR + (64 + st) * LSTR + sc8) = pack8(fr);
            *(uint4*)(sBK + st * LSTR + sc8) = pack8(fb); *(uint4*)(sBK + (64 + st) * LSTR + sc8) = pack8(fk);
        }
        LDS_BARRIER();
        for (int rep2 = 0; rep2 < REP_S2; ++rep2) {
            const int wm = wid >> 2, wn = wid & 3;
#pragma unroll
            for (int mt = 0; mt < 4; ++mt)
#pragma unroll
                for (int nt = 0; nt < 2; ++nt) {
                    const int m0 = wm * 64 + mt * 16, n0 = wn * 32 + nt * 16;
                    const f32x4 c = mma_tile(sAR + m0 * LSTR, sBK + n0 * LSTR, (f32x4){0.f, 0.f, 0.f, 0.f}, lane);
                    const int t = (m0 & 63) + (lane & 15), i0 = (n0 & 63) + (lane >> 4) * 4;
                    if (m0 < 64 && n0 < 64) {
#pragma unroll
                        for (int i = 0; i < 4; ++i) sLAM[t * 64 + i * 16 + (i0 >> 2)] = (i0 + i < t) ? c[i] : 0.f;
                    } else if (m0 < 64) {
                        st_bf4(sAAK + t * LSTR + i0, i0 < t ? c[0] : 0.f, i0 + 1 < t ? c[1] : 0.f, i0 + 2 < t ? c[2] : 0.f, i0 + 3 < t ? c[3] : 0.f);
                    } else {
                        st_bf4((n0 < 64 ? sARB : sARK) + t * LSTR + i0, i0 <= t ? c[0] : 0.f, i0 + 1 <= t ? c[1] : 0.f, i0 + 2 <= t ? c[2] : 0.f, i0 + 3 <= t ? c[3] : 0.f);
                    }
                }
        }
        LDS_BARRIER();
        {
#pragma unroll
            for (int q = 0; q < 2; ++q) {
                const int idx = wid * 2 + q, mt = idx >> 2, nt = idx & 3;
                const f32x4 c = mma_tile_s<false, true>(sAAK, mt * 16, sVT, nt * 16, (f32x4){0.f, 0.f, 0.f, 0.f}, lane);
                *(float4*)(sRHSB + (mt * 16 + (lane & 15)) * 68 + nt * 16 + (lane >> 4) * 4) = make_float4(c[0], c[1], c[2], c[3]);
            }
        }
        LDS_BARRIER();
        for (int rep4 = 0; rep4 < REP_S4; ++rep4) {
            const int col = tid >> 2, q = tid & 3;
            const float* rb = col < 64 ? sRHSA + col : sRHSB + (col - 64);
            float xs[16];
#pragma unroll
            for (int jj = 0; jj < 16; ++jj) xs[jj] = 0.f;
#pragma unroll
            for (int t = 0; t < 64; ++t) {
                const float rhs = rb[t * 68];
                float part = 0.f;
#pragma unroll
                for (int jj = 0; jj * 4 < t; ++jj) part += sLAM[t * 64 + q * 16 + jj] * xs[jj];
                const float xt = rhs + quad_sum(part);
                xs[t >> 2] = (q == (t & 3)) ? xt : xs[t >> 2];
            }
#pragma unroll
            for (int jj = 0; jj < 16; ++jj) sXT[col * LSTR + jj * 4 + q] = f2bf(xs[jj]);
        }
        LDS_BARRIER();
        for (int rep5 = 0; rep5 < REP_S56; ++rep5) {
            bf16_t* RP = (bf16_t*)(ws + R_RP) + (size_t)u * 4096; bf16_t* Yd = (bf16_t*)(ws + R_XM) + (size_t)d * T * D + h * 64;
#pragma unroll
            for (int mt = 0; mt < 4; ++mt) {
                const int t = mt * 16 + (lane & 15), n = (lane >> 4) * 4;
                if (wid < 4) {
                    const f32x4 c = mma_tile(sARB + mt * 16 * LSTR, sXT + wid * 16 * LSTR, (f32x4){0.f, 0.f, 0.f, 0.f}, lane);
                    const bf16_t* rt = sAR + (64 + t) * LSTR + wid * 16 + n;
                    st_bf4(RP + t * 64 + wid * 16 + n, c[0] + bf2f(rt[0]), c[1] + bf2f(rt[1]), c[2] + bf2f(rt[2]), c[3] + bf2f(rt[3]));
                } else {
                    const int v0 = (wid - 4) * 16;
                    f32x4 c = mma_tile(sARB + mt * 16 * LSTR, sXT + (64 + v0) * LSTR, (f32x4){0.f, 0.f, 0.f, 0.f}, lane);
                    c = mma_tile_s<false, true>(sARK, mt * 16, sVT, v0, c, lane);
                    st_bf4(Yd + (size_t)rc_tok(d, ci, t) * D + v0 + n, c[0], c[1], c[2], c[3]);
                }
            }
        }
        {
            bf16_t* MTo = (bf16_t*)(ws + R_MT) + (size_t)u * 4096; bf16_t* NNo = (bf16_t*)(ws + R_NN) + (size_t)u * 4096;
#pragma unroll
            for (int q = 0; q < 2; ++q) {
                const int idx = wid * 2 + q, mt = idx >> 2, nt = idx & 3;
                const int m = mt * 16 + (lane & 15), n = nt * 16 + (lane >> 4) * 4;
                f32x4 c = mma_tile_s<true, false>(sBHT, mt * 16, sXT, nt * 16, (f32x4){0.f, 0.f, 0.f, 0.f}, lane);
                const float gl = sGL[m];
                st_bf4(MTo + m * 64 + n, c[0] + (m == n ? gl : 0.f), c[1] + (m == n + 1 ? gl : 0.f), c[2] + (m == n + 2 ? gl : 0.f), c[3] + (m == n + 3 ? gl : 0.f));
                f32x4 e = mma_tile_s<false, true>(sXT, 64 + mt * 16, sBHT, nt * 16, (f32x4){0.f, 0.f, 0.f, 0.f}, lane);
                e = mma_tile_s<true, true>(sVT, mt * 16, sKHT, nt * 16, e, lane);
                st_bf4(NNo + m * 64 + n, e[0], e[1], e[2], e[3]);
            }
        }
        LDS_BARRIER();
    }
}
constexpr int C_XB = 0, C_BUF0 = 9216, C_RP = 0, C_MT = 9216, C_NN = 18432, C_BUFSZ = 35840;
#define CH_DECL(P) uint4 P##r0, P##r1, P##m0, P##m1; uint2 P##n0
#define CH_LOAD(P, CI) { const int _ci = (CI); const size_t _u = (size_t)dh * NC64 + (_ci < NC64 ? _ci : NC64 - 1); \
    const bf16_t* _RP = (const bf16_t*)(ws + R_RP) + _u * 4096; const bf16_t* _MT = (const bf16_t*)(ws + R_MT) + _u * 4096; const bf16_t* _NN = (const bf16_t*)(ws + R_NN) + _u * 4096; \
    P##r0 = *(const uint4*)(_RP + lt * 8); P##r1 = *(const uint4*)(_RP + (lt + 256) * 8); P##m0 = *(const uint4*)(_MT + lt * 8); P##m1 = *(const uint4*)(_MT + (lt + 256) * 8); \
    P##n0 = *(const uint2*)(_NN + v0 * 64 + lt * 4); }
#define CH_STORE(P, BUF) { unsigned char* _b = (BUF); const int _row0 = lt >> 3, _c8 = (lt & 7) * 8, _rn = lt >> 4, _c4 = (lt & 15) * 4; \
    *(uint4*)((bf16_t*)(_b + C_RP) + _row0 * LSTR + _c8) = P##r0; *(uint4*)((bf16_t*)(_b + C_RP) + (_row0 + 32) * LSTR + _c8) = P##r1; \
    *(uint4*)((bf16_t*)(_b + C_MT) + _row0 * LSTR + _c8) = P##m0; *(uint4*)((bf16_t*)(_b + C_MT) + (_row0 + 32) * LSTR + _c8) = P##m1; \
    *(float4*)((float*)(_b + C_NN) + _rn * 68 + _c4) = make_float4(bflo(P##n0.x), bfhi(P##n0.x), bflo(P##n0.y), bfhi(P##n0.y)); }
__device__ __forceinline__ void chain_update(const unsigned char* buf, bf16_t* xnew, bf16x8 (&sa)[2], int lane) {
    const bf16_t* MTb = (const bf16_t*)(buf + C_MT); const float* NNb = (const float*)(buf + C_NN);
#pragma unroll
    for (int nt = 0; nt < 4; ++nt) {
        f32x4 acc;
#pragma unroll
        for (int i = 0; i < 4; ++i) acc[i] = NNb[((lane >> 4) * 4 + i) * 68 + nt * 16 + (lane & 15)];
#pragma unroll
        for (int ks = 0; ks < 2; ++ks) acc = mfma16(sa[ks], *(const bf16x8*)(MTb + (nt * 16 + (lane & 15)) * LSTR + ks * 32 + (lane >> 4) * 8), acc);
#pragma unroll
        for (int i = 0; i < 4; ++i) xnew[((lane >> 4) * 4 + i) * LSTR + nt * 16 + (lane & 15)] = f2bf(acc[i]);
    }
    WAVE_SYNC();
#pragma unroll
    for (int ks = 0; ks < 2; ++ks) sa[ks] = *(const bf16x8*)(xnew + (lane & 15) * LSTR + ks * 32 + (lane >> 4) * 8);
    WAVE_SYNC();
}
__device__ __forceinline__ void chain_y(const unsigned char* buf, const bf16_t* xprev, bf16_t* Yc, int d, int ci, int lane) {
    const bf16_t* RPb = (const bf16_t*)(buf + C_RP);
    bf16x8 sp[2];
#pragma unroll
    for (int ks = 0; ks < 2; ++ks) sp[ks] = *(const bf16x8*)(xprev + (lane & 15) * LSTR + ks * 32 + (lane >> 4) * 8);
#pragma unroll
    for (int tt = 0; tt < 4; ++tt) {
        f32x4 acc = {0.f, 0.f, 0.f, 0.f};
#pragma unroll
        for (int ks = 0; ks < 2; ++ks) acc = mfma16(sp[ks], *(const bf16x8*)(RPb + (tt * 16 + (lane & 15)) * LSTR + ks * 32 + (lane >> 4) * 8), acc);
        st_bf4(Yc + (size_t)rc_tok(d, ci, tt * 16 + (lane & 15)) * D, acc[0], acc[1], acc[2], acc[3]);
    }
}
__device__ __forceinline__ void phase_rw_chain(const Params& p_, int layer) { const KP p = fresh(p_);
    unsigned char* ws = p.ws; unsigned char* sm = p.sm; const int tid = p.tid, lane = tid & 63, wid = tid >> 6, G = p.G;
    constexpr int NC4 = (NC64 + 3) & ~3;
    for (int item = p.bid; item < 128; item += G) {
        const int dh = ((item >> 3) >> 2) * 8 + (item & 7), v0 = ((item >> 3) & 3) * 16, d = dh >> 4, h = dh & 15;
        LDS_BARRIER();
        if (wid >= 4) {
            const int lt = tid - 256;
            CH_DECL(A); CH_DECL(B); CH_DECL(C); CH_DECL(E);
            CH_LOAD(A, 0) CH_STORE(A, sm + C_BUF0)
            CH_LOAD(A, 1) CH_LOAD(B, 2) CH_LOAD(C, 3) CH_LOAD(E, 4)
            LDS_BARRIER();
            for (int ci = 0; ci < NC4; ci += 4) {
                CH_STORE(A, sm + C_BUF0 + C_BUFSZ) CH_LOAD(A, ci + 5)
                LDS_BARRIER();
                CH_STORE(B, sm + C_BUF0) CH_LOAD(B, ci + 6)
                LDS_BARRIER();
                CH_STORE(C, sm + C_BUF0 + C_BUFSZ) CH_LOAD(C, ci + 7)
                LDS_BARRIER();
                CH_STORE(E, sm + C_BUF0) CH_LOAD(E, ci + 8)
                LDS_BARRIER();
            }
        } else {
            bf16_t* xbuf = (bf16_t*)(sm + C_XB);
            bf16_t* Yc = (bf16_t*)(ws + R_WDEC) + (size_t)d * T * D + h * 64 + v0 + (lane >> 4) * 4;
            bf16x8 sa[2];
#pragma unroll
            for (int ks = 0; ks < 2; ++ks)
#pragma unroll
                for (int i = 0; i < 8; ++i) sa[ks][i] = 0;
            if (wid == 1) { for (int i = lane; i < 16 * LSTR; i += 64) xbuf[16 * LSTR + i] = 0; }
            LDS_BARRIER();
            for (int ci = 0; ci < NC4; ci += 4) {
#pragma unroll
                for (int q = 0; q < 4; ++q) {
                    if (ci + q < NC64) {
                        if (wid == 0) chain_update(sm + C_BUF0 + (q & 1) * C_BUFSZ, xbuf + (q & 1) * 16 * LSTR, sa, lane);
                        else if (wid == 1) chain_y(sm + C_BUF0 + (q & 1) * C_BUFSZ, xbuf + ((q & 1) ^ 1) * 16 * LSTR, Yc, d, ci + q, lane);
                    }
                    LDS_BARRIER();
                }
            }
        }
    }
    if (G > 128) convert_peer_tables(p, layer, 128, G - 128); else convert_peer_tables(p, layer);
}
__device__ __forceinline__ void phase_rw_finish(const Params& p_, int j) { const KP p = fresh(p_);
    unsigned char* ws = p.ws; const int lane = p.tid & 63, gw = p.bid * 8 + (p.tid >> 6), nw = p.G * 8;
    const bf16_t* YF = (const bf16_t*)(ws + R_XM); const bf16_t* YB = YF + (size_t)T * D;
#pragma unroll 1
    for (int tok = gw; tok < T; tok += nw) {
        float b0 = 0.f, b1 = 0.f;
        {
            float r[16], k[16], a0[16], a1[16], ka[16], rk[16];
            row_ld_bf(r, (const bf16_t*)(ws + R_RB) + (size_t)tok * D, lane); row_ld_bf(k, (const bf16_t*)(ws + R_KB) + (size_t)tok * D, lane);
            row_ld_bf(a0, (const bf16_t*)(ws + R_AA) + (size_t)tok * D, lane); row_ld_bf(a1, (const bf16_t*)(ws + R_AA) + ((size_t)T + tok) * D, lane);
            row_ld(ka, p.in(25) + (size_t)j * D, lane); row_ld(rk, p.in(26) + (size_t)j * D, lane);
#pragma unroll
            for (int i = 0; i < 16; ++i) { const float kbar = k[i] * (1.f + (0.5f * (a0[i] + a1[i]) - 1.f) * ka[i]); const float t = r[i] * kbar * rk[i]; if (i < 8) b0 += t; else b1 += t; }
#pragma unroll
            for (int m = 4; m >= 1; m >>= 1) { b0 += __shfl_xor(b0, m); b1 += __shfl_xor(b1, m); }
        }
        float y[16];
        {
            float t2[16];
            row_ld_bf(y, YF + (size_t)tok * D, lane); row_ld_bf(t2, YB + (size_t)tok * D, lane);
#pragma unroll
            for (int i = 0; i < 16; ++i) y[i] += t2[i];
            row_ld_bf(t2, (const bf16_t*)(ws + R_WDEC) + (size_t)tok * D, lane);
#pragma unroll
            for (int i = 0; i < 16; ++i) y[i] += t2[i];
            row_ld_bf(t2, (const bf16_t*)(ws + R_WDEC) + ((size_t)T + tok) * D, lane);
#pragma unroll
            for (int i = 0; i < 16; ++i) y[i] += t2[i];
        }
        float s0 = 0.f, s1 = 0.f;
#pragma unroll
        for (int i = 0; i < 8; ++i) { s0 += y[i]; s1 += y[8 + i]; }
#pragma unroll
        for (int m = 4; m >= 1; m >>= 1) { s0 += __shfl_xor(s0, m); s1 += __shfl_xor(s1, m); }
        const float mu0 = s0 * (1.f / 64.f), mu1 = s1 * (1.f / 64.f);
        float q0 = 0.f, q1 = 0.f;
#pragma unroll
        for (int i = 0; i < 8; ++i) { const float a = y[i] - mu0, b = y[8 + i] - mu1; q0 += a * a; q1 += b * b; }
#pragma unroll
        for (int m = 4; m >= 1; m >>= 1) { q0 += __shfl_xor(q0, m); q1 += __shfl_xor(q1, m); }
        const float r0 = rsqrtf(q0 * (1.f / 64.f) + 64e-5f), r1 = rsqrtf(q1 * (1.f / 64.f) + 64e-5f);
        {
            float lg[16], lb[16];
            row_ld(lg, p.in(27) + (size_t)j * D, lane); row_ld(lb, p.in(28) + (size_t)j * D, lane);
#pragma unroll
            for (int i = 0; i < 8; ++i) { y[i] = (y[i] - mu0) * r0 * lg[i] + lb[i]; y[8 + i] = (y[8 + i] - mu1) * r1 * lg[8 + i] + lb[8 + i]; }
        }
        {
            float v[16], g[16];
            row_ld_bf(v, (const bf16_t*)(ws + R_VB) + (size_t)tok * D, lane); row_ld_bf(g, (const bf16_t*)(ws + R_GG) + (size_t)tok * D, lane);
#pragma unroll
            for (int i = 0; i < 8; ++i) { y[i] = (y[i] + b0 * v[i]) * g[i]; y[8 + i] = (y[8 + i] + b1 * v[8 + i]) * g[8 + i]; }
        }
        row_st_bf((bf16_t*)(ws + R_OUTB) + (size_t)tok * D, y, lane);
    }
}

__device__ __forceinline__ unsigned ord_key(float f) { const unsigned u = f2u(f); return u ^ ((u >> 31) ? 0xffffffffu : 0x80000000u); }
__device__ __forceinline__ float ord_val(unsigned k) { const unsigned u = (k >> 31) ? (k ^ 0x80000000u) : ~k; return u2f(u); }
__device__ __forceinline__ void phase_peer_q(const Params& p_, int layer, unsigned char* smem) { const KP p = fresh(p_);
    unsigned char* ws = p.ws; const int G = p.G, c0 = (layer == DEPTH - 1) ? NCC : 0;
    const bf16_t* HB = (const bf16_t*)(ws + O_HB); const bf16_t* W = (const bf16_t*)(ws + O_WQ) + (size_t)layer * 2048 * 1024; bf16_t* QP = (bf16_t*)(ws + P_QP);
    big_gemm(p, smem, HB, W, 2048, c0 == 0, [&](int row, int col, const f32x4& v) { st_bf4(QP + (size_t)row * 2048 + col, v[0], v[1], v[2], v[3]); });
}
#define KCE(x, y) { const unsigned _hi = (x) > (y) ? (x) : (y), _lo = (x) > (y) ? (y) : (x); (x) = _hi; (y) = _lo; }
__device__ __forceinline__ void bitonic_merge16(unsigned* a) {
#pragma unroll
    for (int j = 8; j > 0; j >>= 1)
#pragma unroll
        for (int i = 0; i < 16; ++i) if ((i & j) == 0) KCE(a[i], a[i | j])
}
__device__ __forceinline__ void bitonic_sort16(unsigned* a) {
#pragma unroll
    for (int k = 2; k <= 16; k <<= 1)
#pragma unroll
        for (int j = k >> 1; j > 0; j >>= 1)
#pragma unroll
            for (int i = 0; i < 16; ++i) { const int l = i ^ j; if (l > i) { if ((i & k) == 0 || k == 16) KCE(a[i], a[l]) else KCE(a[l], a[i]) } }
}
__device__ __forceinline__ unsigned quad_xchg(unsigned v, int step) {
#ifdef CPU_EMU
    return __shfl_xor(v, step);
#else
    return step == 1 ? (unsigned)__builtin_amdgcn_update_dpp(0, (int)v, 0xB1, 0xF, 0xF, true) : (unsigned)__builtin_amdgcn_update_dpp(0, (int)v, 0x4E, 0xF, 0xF, true);
#endif
}
__device__ __forceinline__ void phase_peer_scores(const Params& p_, int layer, unsigned char* smem) { const KP p = fresh(p_);
    unsigned char* ws = p.ws; const int G = p.G, tid = p.tid, c0 = (layer == DEPTH - 1) ? NCC : 0;
    const bf16_t* QP = (const bf16_t*)(ws + P_QP); const bf16_t* KEYS = (const bf16_t*)(ws + O_KEYS) + (size_t)layer * 16 * 128 * 128; unsigned* TK = (unsigned*)(ws + P_TK);
    float* sc = (float*)smem;
    for (int t = p.bid; t < (NCH - c0) * 16; t += G) {
        const int m0 = (c0 + t / 16) * 128, hp = t % 16;
        f32x4 acc[4][2];
        gemm_core(p.tid, mkseg(QP + (size_t)m0 * 2048 + hp * 128, 2048, KEYS + (size_t)hp * 128 * 128, 128, 128), mkseg(QP, 0, QP, 0, 0), mkseg(QP, 0, QP, 0, 0), smem, acc);
        ACC_FOREACH({ *(float4*)(sc + m * 132 + n) = make_float4(v[0], v[1], v[2], v[3]); })
        LDS_BARRIER();
        {
            const int row = tid >> 2, q = tid & 3;
            unsigned ka[16], kb[16];
#pragma unroll
            for (int c = 0; c < 16; ++c) {
                ka[c] = (ord_key(sc[row * 132 + 4 * c + q]) & ~127u) | (unsigned)(127 - (4 * c + q));
                kb[c] = (ord_key(sc[row * 132 + 64 + 4 * c + q]) & ~127u) | (unsigned)(127 - (64 + 4 * c + q));
            }
            bitonic_sort16(ka); bitonic_sort16(kb);
#pragma unroll
            for (int i = 0; i < 16; ++i) ka[i] = ka[i] > kb[15 - i] ? ka[i] : kb[15 - i];
            bitonic_merge16(ka);
#pragma unroll
            for (int step = 1; step <= 2; ++step) {
#pragma unroll
                for (int i = 0; i < 16; ++i) kb[i] = quad_xchg(ka[15 - i], step);
#pragma unroll
                for (int i = 0; i < 16; ++i) ka[i] = ka[i] > kb[i] ? ka[i] : kb[i];
                bitonic_merge16(ka);
            }
            if (q == 0) {
                uint4* o = (uint4*)(TK + ((size_t)(m0 + row) * 16 + hp) * 16);
                o[0] = make_uint4(ka[0], ka[1], ka[2], ka[3]); o[1] = make_uint4(ka[4], ka[5], ka[6], ka[7]);
                o[2] = make_uint4(ka[8], ka[9], ka[10], ka[11]); o[3] = make_uint4(ka[12], ka[13], ka[14], ka[15]);
            }
        }
        LDS_BARRIER();
    }
}
__device__ __forceinline__ void phase_peer_select(const Params& p_, int layer) { const KP p = fresh(p_);
    unsigned char* ws = p.ws; const int t_begin = (layer == DEPTH - 1) ? CTX : 0;
    const unsigned* TK = (const unsigned*)(ws + P_TK); int* EIDX = (int*)(ws + P_EIDX); float* GATE = (float*)(ws + P_GATE);
    const int gtid = p.bid * NT + p.tid, gstride = p.G * NT;
    for (int it = gtid; it < (T - t_begin) * 8; it += gstride) {
        const int tok = t_begin + (it >> 3), h = it & 7;
        unsigned k0[16], k1[16];
        { const uint4* q = (const uint4*)(TK + ((size_t)tok * 16 + h * 2) * 16);
#pragma unroll
          for (int i = 0; i < 4; ++i) { const uint4 a = q[i], b = q[4 + i]; k0[4 * i] = a.x; k0[4 * i + 1] = a.y; k0[4 * i + 2] = a.z; k0[4 * i + 3] = a.w; k1[4 * i] = b.x; k1[4 * i + 1] = b.y; k1[4 * i + 2] = b.z; k1[4 * i + 3] = b.w; } }
        unsigned long long top[16];
#pragma unroll
        for (int i = 0; i < 16; ++i) top[i] = 0ull;
#pragma unroll
        for (int i = 0; i < 16; ++i)
#pragma unroll
            for (int jj = 0; jj < 16; ++jj)
                if ((i + 1) * (jj + 1) <= 16) {
                    const float v = ord_val(k0[i] & ~127u) + ord_val(k1[jj] & ~127u);
                    const unsigned e = (127u - (k0[i] & 127u)) * 128u + (127u - (k1[jj] & 127u));
                    unsigned long long x = ((unsigned long long)ord_key(v) << 32) | ((unsigned long long)(255 - (i * 16 + jj)) << 16) | e;
#pragma unroll
                    for (int q = 0; q < 16; ++q) { const unsigned long long hi = top[q] > x ? top[q] : x; x = top[q] > x ? x : top[q]; top[q] = hi; }
                }
        const float vmax = ord_val((unsigned)(top[0] >> 32));
        float ex[16], sum = 0.f;
#pragma unroll
        for (int q = 0; q < 16; ++q) { ex[q] = fexp(ord_val((unsigned)(top[q] >> 32)) - vmax); sum += ex[q]; }
        const float inv = 1.f / sum;
#pragma unroll
        for (int q = 0; q < 16; ++q) { EIDX[(size_t)tok * 128 + h * 16 + q] = (int)(top[q] & 0x3fffu); GATE[(size_t)tok * 128 + h * 16 + q] = ex[q] * inv; }
    }
}
#if PEER_FP6
__device__ __forceinline__ void row2_ld(float* v, const float* p, int l31) {
#pragma unroll
    for (int q = 0; q < 8; ++q) { const float4 a = *(const float4*)(p + l31 * 32 + q * 4); v[q * 4] = a.x; v[q * 4 + 1] = a.y; v[q * 4 + 2] = a.z; v[q * 4 + 3] = a.w; }
}
__device__ __forceinline__ float half_sum_sel(float v, int half) {
#ifdef CPU_EMU
    for (int o = 16; o >= 1; o >>= 1) v += __shfl_xor(v, o);
    return v;
#else
    v += __int_as_float(__builtin_amdgcn_update_dpp(0, __float_as_int(v), 0xB1, 0xF, 0xF, true));
    v += __int_as_float(__builtin_amdgcn_update_dpp(0, __float_as_int(v), 0x4E, 0xF, 0xF, true));
    v += __int_as_float(__builtin_amdgcn_update_dpp(0, __float_as_int(v), 0x141, 0xF, 0xF, true));
    v += __int_as_float(__builtin_amdgcn_update_dpp(0, __float_as_int(v), 0x140, 0xF, 0xF, true));
    v += __int_as_float(__builtin_amdgcn_update_dpp(0, __float_as_int(v), 0x142, 0xA, 0xF, false));
    const float s0 = __int_as_float(__builtin_amdgcn_readlane(__float_as_int(v), 31)), s1 = __int_as_float(__builtin_amdgcn_readlane(__float_as_int(v), 63));
    return half ? s1 : s0;
#endif
}
__device__ __forceinline__ void phase_peer_experts(const Params& p_, int layer) { const KP p = fresh(p_);
    unsigned char* ws = p.ws; const int lane = p.tid & 63, l31 = lane & 31, half = lane >> 5, gw = p.bid * 8 + (p.tid >> 6), nw = p.G * 8;
    const bool last = layer == DEPTH - 1; const int t_begin = last ? CTX : 0;
    float* XS = (float*)(ws + O_XS); const unsigned char* UT = ws + O_UT; const unsigned char* VTb = ws + O_VT2;
    const float* US = (const float*)(ws + O_US); const float* VS = (const float*)(ws + O_VS);
    const int* EIDX = (const int*)(ws + P_EIDX); const float* GATE = (const float*)(ws + P_GATE);
    const float* lg = p.in(6) + (size_t)(layer * 2 + 1) * D; const float* lb = p.in(7) + (size_t)(layer * 2 + 1) * D;
    for (int tok = t_begin + gw; tok < T; tok += nw) {
        float hx[32], acc[32];
        { const uint4* hp = (const uint4*)((const bf16_t*)(ws + O_HB) + (size_t)tok * D + l31 * 32);
#pragma unroll
          for (int q = 0; q < 4; ++q) unpack8(hp[q], hx + 8 * q); }
        const int eA = EIDX[(size_t)tok * 128 + lane], eB = EIDX[(size_t)tok * 128 + 64 + lane];
        const float gA = GATE[(size_t)tok * 128 + lane], gB = GATE[(size_t)tok * 128 + 64 + lane];
        for (int rep_ = 0; rep_ < REP_GATHER; ++rep_) {
#pragma unroll
        for (int i = 0; i < 32; ++i) acc[i] = 0.f;
#pragma unroll
        for (int hh = 0; hh < 2; ++hh) {
            const int ev = hh ? eB : eA; const float gv = hh ? gB : gA;
            for (int e0 = 0; e0 < 64; e0 += 8) {
                uint4 ura[4], vra[4]; uint2 urc[4], vrc[4]; float gt[4], us[4], vs[4];
#pragma unroll
                for (int q = 0; q < 4; ++q) {
#ifdef CPU_EMU
                    const int i0 = __shfl(ev, e0 + 2 * q), i1 = __shfl(ev, e0 + 2 * q + 1); const float g0 = __shfl(gv, e0 + 2 * q), g1 = __shfl(gv, e0 + 2 * q + 1);
#else
                    const int i0 = __builtin_amdgcn_readlane(ev, e0 + 2 * q), i1 = __builtin_amdgcn_readlane(ev, e0 + 2 * q + 1);
                    const float g0 = __int_as_float(__builtin_amdgcn_readlane(__float_as_int(gv), e0 + 2 * q)), g1 = __int_as_float(__builtin_amdgcn_readlane(__float_as_int(gv), e0 + 2 * q + 1));
#endif
                    const int idx = half ? i1 : i0; gt[q] = half ? g1 : g0;
                    const unsigned char* up = UT + (size_t)idx * 768; const unsigned char* vp = VTb + (size_t)idx * 768;
                    ura[q] = *(const uint4*)(up + l31 * 16); urc[q] = *(const uint2*)(up + 512 + l31 * 8); vra[q] = *(const uint4*)(vp + l31 * 16); vrc[q] = *(const uint2*)(vp + 512 + l31 * 8);
                    us[q] = US[idx]; vs[q] = VS[idx];
                }
#pragma unroll
                for (int q = 0; q < 4; ++q) {
                    float f[32];
                    { const unsigned w[6] = {ura[q].x, ura[q].y, ura[q].z, ura[q].w, urc[q].x, urc[q].y}; fp6x32_dec(w, f); }
                    float s = 0.f;
#pragma unroll
                    for (int i = 0; i < 32; ++i) s += f[i] * hx[i];
                    s = half_sum_sel(s, half) * us[q];
                    const float wgt = gt[q] * 0.5f * s * (1.f + erff(s * 0.70710678118f)) * vs[q];
                    { const unsigned w[6] = {vra[q].x, vra[q].y, vra[q].z, vra[q].w, vrc[q].x, vrc[q].y}; fp6x32_dec(w, f); }
#pragma unroll
                    for (int i = 0; i < 32; ++i) acc[i] += wgt * f[i];
                }
            }
        }
        }
        float x[32];
        row2_ld(x, XS + (size_t)tok * D, l31);
        { float g[32]; { const uint4* gp_ = (const uint4*)(ws + O_CROW + ((unsigned)(layer * 4 + (tok < CTX ? 1 : 0)) * 2048u + (unsigned)l31 * 64u));
#pragma unroll
            for (int q = 0; q < 4; ++q) unpack8(gp_[q], g + 8 * q); }
#pragma unroll
          for (int i = 0; i < 32; ++i) { const float a = acc[i] + __shfl_xor(acc[i], 32); x[i] = DN_ALPHA * x[i] + g[i] * a; } }
        {
            float s = 0.f;
#pragma unroll
            for (int i = 0; i < 32; ++i) s += x[i];
            const float mu = wave_sum(s) * (1.f / 2048.f);
            float q = 0.f;
#pragma unroll
            for (int i = 0; i < 32; ++i) { const float dd = x[i] - mu; q += dd * dd; }
            const float rs = rsqrtf(wave_sum(q) * (1.f / 2048.f) + 1e-5f);
            float gg[32], bb[32]; { const uint4* gp_ = (const uint4*)(ws + O_CROW + ((unsigned)(layer * 4 + 2) * 2048u + (unsigned)l31 * 64u)); const uint4* bp_ = (const uint4*)(ws + O_CROW + ((unsigned)(layer * 4 + 3) * 2048u + (unsigned)l31 * 64u));
#pragma unroll
              for (int q = 0; q < 4; ++q) { unpack8(gp_[q], gg + 8 * q); unpack8(bp_[q], bb + 8 * q); } }
#pragma unroll
            for (int i = 0; i < 32; ++i) x[i] = (x[i] - mu) * rs * gg[i] + bb[i];
        }
        float* dstrow = last ? p.out() + (size_t)(tok - CTX) * D : XS + (size_t)tok * D;
        if (half == 0) {
#pragma unroll
            for (int q = 0; q < 8; ++q) *(float4*)(dstrow + l31 * 32 + q * 4) = make_float4(x[q * 4], x[q * 4 + 1], x[q * 4 + 2], x[q * 4 + 3]);
        }
        if (!last && ((layer + 1) & 1) == 0) {
            const int nl = layer + 1, j = nl >> 1;
            float sh[32], sc[32]; row2_ld(sh, modp(p, nl, tok, 0), l31); row2_ld(sc, modp(p, nl, tok, 1), l31);
#pragma unroll
            for (int i = 0; i < 32; ++i) x[i] = x[i] * (1.f + sc[i]) + sh[i];
            if (half == 0) {
                bf16_t* hb = (bf16_t*)(ws + O_HB) + (size_t)tok * D + l31 * 32;
#pragma unroll
                for (int q = 0; q < 4; ++q) *(uint4*)(hb + q * 8) = pack8(x + q * 8);
            }
        }
    }
}
#else
__device__ __forceinline__ void phase_peer_experts(const Params& p_, int layer) { const KP p = fresh(p_);
    unsigned char* ws = p.ws; const int lane = p.tid & 63, gw = p.bid * 8 + (p.tid >> 6), nw = p.G * 8;
    const bool last = layer == DEPTH - 1; const int t_begin = last ? CTX : 0;
    float* XS = (float*)(ws + O_XS); const unsigned char* UT = ws + O_UT; const unsigned char* VTb = ws + O_VT2;
    const float* US = (const float*)(ws + O_US); const float* VS = (const float*)(ws + O_VS);
    const int* EIDX = (const int*)(ws + P_EIDX); const float* GATE = (const float*)(ws + P_GATE);
    const float* lg = p.in(6) + (size_t)(layer * 2 + 1) * D; const float* lb = p.in(7) + (size_t)(layer * 2 + 1) * D;
    for (int tok = t_begin + gw; tok < T; tok += nw) {
        float x[16], hx[16], acc[16];
        row_ld<1>(x, XS + (size_t)tok * D, lane);
        { float sh[16], sc[16]; row_ld<1>(sh, modp(p, layer, tok, 3), lane); row_ld<1>(sc, modp(p, layer, tok, 4), lane);
#pragma unroll
          for (int i = 0; i < 16; ++i) hx[i] = x[i] * (1.f + sc[i]) + sh[i]; }
        for (int rep_ = 0; rep_ < REP_GATHER; ++rep_) {
#pragma unroll
        for (int i = 0; i < 16; ++i) acc[i] = 0.f;
        const int eA = EIDX[(size_t)tok * 128 + lane], eB = EIDX[(size_t)tok * 128 + 64 + lane];
        const float gA = GATE[(size_t)tok * 128 + lane], gB = GATE[(size_t)tok * 128 + 64 + lane];
#pragma unroll
        for (int half = 0; half < 2; ++half) {
            const int ev = half ? eB : eA; const float gv = half ? gB : gA;
            for (int e0 = 0; e0 < 64; e0 += 8) {
                uint4 ua[8], va[8]; float gt[8], us[8], vs[8];
#pragma unroll
                for (int q = 0; q < 8; ++q) {
#ifdef CPU_EMU
                    const int idx = __shfl(ev, e0 + q); gt[q] = __shfl(gv, e0 + q);
#else
                    const int idx = __builtin_amdgcn_readlane(ev, e0 + q); gt[q] = __int_as_float(__builtin_amdgcn_readlane(__float_as_int(gv), e0 + q));
#endif
                    ua[q] = *(const uint4*)(UT + (size_t)idx * 1024 + lane * 16); va[q] = *(const uint4*)(VTb + (size_t)idx * 1024 + lane * 16);
                    us[q] = US[idx]; vs[q] = VS[idx];
                }
#pragma unroll
                for (int q = 0; q < 8; ++q) {
                    float f[16]; fp8x16_dec(ua[q], f);
                    float s = 0.f;
#pragma unroll
                    for (int i = 0; i < 16; ++i) s += f[i] * hx[i];
                    s = wave_sum_fast(s) * us[q];
                    const float wgt = gt[q] * 0.5f * s * (1.f + erff(s * 0.70710678118f)) * vs[q];
                    fp8x16_dec(va[q], f);
#pragma unroll
                    for (int i = 0; i < 16; ++i) acc[i] += wgt * f[i];
                }
            }
        }
        }
        { float g[16]; row_ld<1>(g, modp(p, layer, tok, 5), lane);
#pragma unroll
          for (int i = 0; i < 16; ++i) x[i] = DN_ALPHA * x[i] + g[i] * acc[i]; }
        row_layernorm<1>(x, lg, lb, lane);
        if (last) row_st<1>(p.out() + (size_t)(tok - CTX) * D, x, lane);
        else { row_st<1>(XS + (size_t)tok * D, x, lane); emit_layer_input<1>(p, layer + 1, tok, x, lane); }
    }
}

#endif

#ifdef CPU_EMU
int g_stop_phase = 1000000;
#define PHASE_END() do { grid_sync(kp); if (++phase_no >= g_stop_phase) return; } while (0)
#else
#ifndef STOP_PHASE
#define STOP_PHASE 1000000
#endif
#define PHASE_END() do { grid_sync(kp); if (++phase_no >= STOP_PHASE) return; } while (0)
#endif

__global__ void __launch_bounds__(NT) fwd_megakernel(Params kp) {
    SMEM_DECL;
    const Params& p = kp;
    int phase_no = 0; (void)phase_no;
    (void)gridbar_init((unsigned*)(kp.ws + O_BAR), smem + LDS_BYTES - 16);
    if (PH_MASK & (1u << 0)) { phase_setup(p, smem); if (DUP_MASK & (1u << 0)) { phase_setup(p, smem); } } PHASE_END();
    if (PH_MASK & (1u << 1)) { phase_emit0(p); if (DUP_MASK & (1u << 1)) { phase_emit0(p); } } PHASE_END();
#pragma unroll 1
    for (int layer = 0; layer < DEPTH; ++layer) {
        const int j = layer >> 1;
        size_t Y;
        if ((layer & 1) == 0) {
            phase_ml_gates(p, j, smem); PHASE_END();
            if (PH_MASK & (1u << 2)) { phase_ml_inproj(p, j, smem); if (DUP_MASK & (1u << 2)) { phase_ml_inproj(p, j, smem); } } PHASE_END();
            if (PH_MASK & (1u << 3)) { phase_ml_conv(p, j, smem); if (DUP_MASK & (1u << 3)) { phase_ml_conv(p, j, smem); } } PHASE_END();
            if (PH_MASK & (1u << 4)) { phase_ml_kvloc(p, smem); if (DUP_MASK & (1u << 4)) { phase_ml_kvloc(p, smem); } } PHASE_END();
            if (PH_MASK & (1u << 5)) { phase_ml_scan(p, layer); if (DUP_MASK & (1u << 5)) { phase_ml_scan(p, layer); } } PHASE_END();
            if (PH_MASK & (1u << 6)) { phase_ml_scores(p, j, smem); if (DUP_MASK & (1u << 6)) { phase_ml_scores(p, j, smem); } } PHASE_END();
            if (PH_MASK & (1u << 9)) { phase_proj_out(p, M_VB, O_WOUTM + (size_t)j * 1024 * 1024 * 2, M_KVLOC, smem); if (DUP_MASK & (1u << 9)) { phase_proj_out(p, M_VB, O_WOUTM + (size_t)j * 1024 * 1024 * 2, M_KVLOC, smem); } } PHASE_END();
            Y = M_KVLOC;
        } else {
            if (PH_MASK & (1u << 10)) { phase_rw_mix(p, layer); if (DUP_MASK & (1u << 10)) { phase_rw_mix(p, layer); } } PHASE_END();
            if (PH_MASK & (1u << 11)) { phase_rw_proj1(p, j, smem); if (DUP_MASK & (1u << 11)) { phase_rw_proj1(p, j, smem); } } PHASE_END();
            if (PH_MASK & (1u << 12)) { phase_rw_proj2(p, j, smem); if (DUP_MASK & (1u << 12)) { phase_rw_proj2(p, j, smem); } } PHASE_END();
            if (PH_MASK & (1u << 14)) { phase_rw_chunk(p, j); if (DUP_MASK & (1u << 14)) { phase_rw_chunk(p, j); } } PHASE_END();
            if (PH_MASK & (1u << 13)) { phase_rw_chain(p, layer); if (DUP_MASK & (1u << 13)) { phase_rw_chain(p, layer); } } PHASE_END();
            if (PH_MASK & (1u << 15)) { phase_rw_finish(p, j); if (DUP_MASK & (1u << 15)) { phase_rw_finish(p, j); } } PHASE_END();
            if (PH_MASK & (1u << 16)) { phase_proj_out(p, R_OUTB, O_WOUTR + (size_t)j * 1024 * 1024 * 2, R_XM + (size_t)2 * T * D * 4, smem); if (DUP_MASK & (1u << 16)) { phase_proj_out(p, R_OUTB, O_WOUTR + (size_t)j * 1024 * 1024 * 2, R_XM + (size_t)2 * T * D * 4, smem); } } PHASE_END();
            Y = R_XM + (size_t)2 * T * D * 4;
        }
        if (PH_MASK & (1u << 17)) { phase_ln_mid(p, layer, Y); if (DUP_MASK & (1u << 17)) { phase_ln_mid(p, layer, Y); } } PHASE_END();
        if (PH_MASK & (1u << 18)) { phase_peer_q(p, layer, smem); if (DUP_MASK & (1u << 18)) { phase_peer_q(p, layer, smem); } } PHASE_END();
        if (PH_MASK & (1u << 19)) { phase_peer_scores(p, layer, smem); if (DUP_MASK & (1u << 19)) { phase_peer_scores(p, layer, smem); } } PHASE_END();
        if (PH_MASK & (1u << 20)) { phase_peer_select(p, layer); if (DUP_MASK & (1u << 20)) { phase_peer_select(p, layer); } } PHASE_END();
        if (PH_MASK & (1u << 21)) { phase_peer_experts(p, layer); if (DUP_MASK & (1u << 21)) { phase_peer_experts(p, layer); } } PHASE_END();
    }
}
}

#ifdef CPU_EMU
static void emu_entry(void* a) { fwd_megakernel(*(Params*)a); }
size_t emu_ws_need() { return WS_NEED; }
void emu_set_stop(int n) { g_stop_phase = n; }
size_t emu_off(const char* n) {
#define OFF(x) if (!strcmp(n, #x)) return x;
    OFF(O_MOD) OFF(O_XS) OFF(O_HB) OFF(O_GATES) OFF(O_WIN) OFF(M_PQK) OFF(M_VB) OFF(M_OB) OFF(M_QB) OFF(M_KB) OFF(M_KAT) OFF(M_VT) OFF(M_BCUM) OFF(M_AS) OFF(M_PMAX)
    OFF(M_KVLOC) OFF(M_CIN) OFF(M_PBUF) OFF(M_QF) OFF(M_QBW) OFF(M_NIN) OFF(M_MIN) OFF(R_XM) OFF(R_RB) OFF(R_KB) OFF(R_VB) OFF(R_WDEC) OFF(R_AA) OFF(R_GG) OFF(R_OUTB)
    OFF(P_QP) OFF(P_TK) OFF(P_EIDX) OFF(P_GATE) OFF(R_LW1) OFF(R_LA1) OFF(R_LG1)
    return (size_t)-1;
}
#endif

extern "C" void kernel_launch(void* const* d_in, const int* in_sizes, int n_in, void* d_out, int out_size, void* d_ws, size_t ws_size, hipStream_t stream) {
    Params p{};
    for (int i = 0; i < 34; ++i) p.in[i] = (const float*)d_in[i];
    p.out = (float*)d_out; p.ws = (unsigned char*)d_ws;
#ifdef CPU_EMU
    int grid = getenv("EMU_GRID") ? atoi(getenv("EMU_GRID")) : 4;
    emu_launch(emu_entry, &p, grid, NT, LDS_BYTES);
#else
    static int grid_blocks = 0;
    if (!grid_blocks) {
        if (n_in != 34 || ws_size < WS_NEED) { fprintf(stderr, "kernel_launch: unexpected inputs (n_in %d, ws %zu, need %zu)\n", n_in, ws_size, (size_t)WS_NEED); grid_blocks = -1; return; }
        int dev = 0, cus = 0, per_cu = 0;
        hipGetDevice(&dev);
        hipDeviceGetAttribute(&cus, hipDeviceAttributeMultiprocessorCount, dev);
        hipFuncSetAttribute((const void*)fwd_megakernel, hipFuncAttributeMaxDynamicSharedMemorySize, LDS_BYTES);
        hipOccupancyMaxActiveBlocksPerMultiprocessor(&per_cu, (const void*)fwd_megakernel, NT, LDS_BYTES);
        if (per_cu < 1) { fprintf(stderr, "kernel_launch: occupancy query says %d blocks per CU\n", per_cu); grid_blocks = -1; return; }
        grid_blocks = cus;
    }
    if (grid_blocks < 0) return;
    hipMemsetAsync((char*)d_ws + O_BAR, 0, 16384, stream);
    void* args[] = {&p};
    hipError_t e = hipLaunchCooperativeKernel((const void*)fwd_megakernel, dim3(grid_blocks), dim3(NT), args, LDS_BYTES, stream);
    if (e != hipSuccess) fprintf(stderr, "cooperative launch failed: %s (grid %d)\n", hipGetErrorString(e), grid_blocks);
#endif
}
```

```cpp
#ifndef CPU_EMU
#include <hip/hip_runtime.h>
#include <hip/hip_cooperative_groups.h>
#include <cstdio>
#endif
#ifndef USE_CG_SYNC
#define USE_CG_SYNC 0
#endif
#include <stdint.h>
#include <math.h>

#ifndef PH_MASK
#define PH_MASK 0xffffffffu
#endif
#ifndef DUP_MASK
#define DUP_MASK 0u
#endif
#ifndef REP_GATHER
#define REP_GATHER 1
#endif
#ifndef REP_S4
#define REP_S4 1
#endif
#ifndef REP_S2
#define REP_S2 1
#endif
#ifndef REP_S56
#define REP_S56 1
#endif
#ifndef PEER_FP6
#define PEER_FP6 1
#endif
#ifndef CFG_SEQ
#define CFG_SEQ 16384
#endif
#ifndef CFG_CTX
#define CFG_CTX 256
#endif
#ifndef CFG_DEPTH
#define CFG_DEPTH 4
#endif

namespace {
typedef unsigned short bf16_t;
typedef short bf16x8 __attribute__((ext_vector_type(8)));
typedef float f32x4 __attribute__((ext_vector_type(4)));

constexpr int D = 1024, SEQ = CFG_SEQ, CTX = CFG_CTX, DEPTH = CFG_DEPTH, T = SEQ + CTX, NCH = T / 128, NCC = CTX / 128, ROWS = SEQ / 64;
constexpr int NA = (DEPTH + 1) / 2, NB = DEPTH / 2, NT = 512;
constexpr float DN_ALPHA = 1.681792830507429f;
constexpr int MPROJ = 4 * D + 16;
constexpr int LDS_BYTES = 150528;

constexpr size_t al(size_t x) { return (x + 255) & ~(size_t)255; }
constexpr size_t O_BAR = 0;
constexpr size_t O_MOD = al(O_BAR + 16384);
constexpr size_t O_XS = al(O_MOD + (size_t)DEPTH * 2 * 6144 * 4);
constexpr size_t O_HB = al(O_XS + (size_t)T * D * 4);
constexpr size_t O_GATES = al(O_HB + (size_t)T * D * 2);
constexpr size_t O_WIN = al(O_GATES + (size_t)T * 16 * 4);
constexpr size_t O_WING = al(O_WIN + (size_t)NA * 4096 * 1024 * 2);
constexpr size_t O_WOUTM = al(O_WING + (size_t)NA * 16 * 1024 * 4);
constexpr size_t O_WRKV = al(O_WOUTM + (size_t)NA * 1024 * 1024 * 2);
constexpr size_t O_W1C = al(O_WRKV + (size_t)NB * 3 * 1024 * 1024 * 2);
constexpr size_t O_A1C = al(O_W1C + (size_t)NB * 128 * 1024 * 2);
constexpr size_t O_G1 = al(O_A1C + (size_t)NB * 128 * 1024 * 2);
constexpr size_t O_W2 = al(O_G1 + (size_t)NB * 256 * 1024 * 2);
constexpr size_t O_A2 = al(O_W2 + (size_t)NB * 2 * 1024 * 64 * 2);
constexpr size_t O_G2 = al(O_A2 + (size_t)NB * 2 * 1024 * 64 * 2);
constexpr size_t O_WOUTR = al(O_G2 + (size_t)NB * 1024 * 192 * 2);
constexpr size_t O_WQ = al(O_WOUTR + (size_t)NB * 1024 * 1024 * 2);
constexpr size_t O_KEYS = al(O_WQ + (size_t)DEPTH * 2048 * 1024 * 2);
constexpr size_t O_UT = al(O_KEYS + (size_t)DEPTH * 16 * 128 * 128 * 2);
constexpr size_t O_VT2 = al(O_UT + (size_t)16384 * 1024);
constexpr size_t O_US = al(O_VT2 + (size_t)16384 * 1024);
constexpr size_t O_VS = al(O_US + (size_t)16384 * 4);
constexpr size_t O_WINGB = al(O_VS + (size_t)16384 * 4);
constexpr size_t O_CROW = al(O_WINGB + (size_t)NA * 128 * 1024 * 2);
constexpr size_t O_SCR = al(O_CROW + (size_t)DEPTH * 4 * 1024 * 2);
constexpr size_t M_PQK = O_SCR;
constexpr size_t M_VB = al(M_PQK + (size_t)T * 2048 * 2);
constexpr size_t M_OB = al(M_VB + (size_t)T * D * 2);
constexpr size_t M_QB = al(M_OB + (size_t)T * D * 2);
constexpr size_t M_KB = al(M_QB + (size_t)T * D * 2);
constexpr size_t M_KAT = al(M_KB + (size_t)T * D * 2);
constexpr size_t M_VT = al(M_KAT + (size_t)2 * D * T * 2);
constexpr size_t M_BCUM = al(M_VT + (size_t)D * T * 2);
constexpr size_t M_AS = al(M_BCUM + (size_t)8 * T * 4);
constexpr size_t M_PMAX = al(M_AS + (size_t)8 * T * 4);
constexpr size_t M_MLOC = al(M_PMAX + (size_t)8 * T * 4);
constexpr size_t M_BLAST = al(M_MLOC + (size_t)8 * NCH * 4);
constexpr size_t M_MIN = al(M_BLAST + (size_t)8 * NCH * 4);
constexpr size_t M_NIN = al(M_MIN + (size_t)8 * NCH * 4);
constexpr size_t M_NLOC = al(M_NIN + (size_t)8 * NCH * 256 * 4);
constexpr size_t M_KVLOC = al(M_NLOC + (size_t)8 * NCH * 256 * 4);
constexpr size_t M_CIN = al(M_KVLOC + (size_t)8 * NCH * 65536 * 2);
constexpr size_t M_PBUF = al(M_CIN + (size_t)8 * NCH * 65536 * 2);
constexpr size_t M_QF = al(M_PBUF + (size_t)4 * NCH * 16384 * 2);
constexpr size_t M_QBW = al(M_QF + (size_t)T * D * 2);
constexpr size_t M_END = al(M_QBW + (size_t)T * D * 2);
constexpr size_t R_XM = O_SCR;
constexpr size_t R_RB = al(R_XM + (size_t)6 * T * D * 2);
constexpr size_t R_KB = al(R_RB + (size_t)T * D * 2);
constexpr size_t R_VB = al(R_KB + (size_t)T * D * 2);
constexpr size_t R_LW1 = al(R_VB + (size_t)T * D * 2);
constexpr size_t R_LA1 = al(R_LW1 + (size_t)T * 128 * 2);
constexpr size_t R_LG1 = al(R_LA1 + (size_t)T * 128 * 2);
constexpr size_t R_WDEC = al(R_LG1 + (size_t)T * 192 * 2);
constexpr size_t R_AA = al(R_WDEC + (size_t)2 * T * D * 4);
constexpr size_t R_GG = al(R_AA + (size_t)2 * T * D * 2);
constexpr size_t R_OUTB = al(R_GG + (size_t)T * D * 2);
constexpr int NC64 = T / 64;
constexpr size_t R_MT = al(R_OUTB + (size_t)T * D * 2);
constexpr size_t R_NN = al(R_MT + (size_t)32 * NC64 * 4096 * 2);
constexpr size_t R_RP = al(R_NN + (size_t)32 * NC64 * 4096 * 4);
constexpr size_t R_END = al(R_RP + (size_t)32 * NC64 * 4096 * 2);
constexpr size_t P_QP = O_SCR;
constexpr size_t P_TK = al(P_QP + (size_t)T * 2048 * 2);
constexpr size_t P_EIDX = al(P_TK + (size_t)T * 256 * 4);
constexpr size_t P_GATE = al(P_EIDX + (size_t)T * 128 * 4);
constexpr size_t P_END = al(P_GATE + (size_t)T * 128 * 4);
constexpr size_t WS_NEED = (M_END > R_END ? (M_END > P_END ? M_END : P_END) : (R_END > P_END ? R_END : P_END));
static_assert(M_KVLOC + (size_t)T * D * 4 <= M_CIN, "Y alias must fit in KVLOC");
static_assert((size_t)T * 2048 * 2 == (size_t)T * D * 4, "HOUT alias");

struct Params {
    const float* in[34];
    float* out;
    unsigned char* ws;
};
constexpr int PTR_TAB = LDS_BYTES - 16 - 40 * 8;

#ifdef CPU_EMU
__device__ __forceinline__ float u2f(unsigned u) { float f; memcpy(&f, &u, 4); return f; }
__device__ __forceinline__ unsigned f2u(float f) { unsigned u; memcpy(&u, &f, 4); return u; }
#define SMEM_DECL unsigned char* smem = emu_smem()
__device__ __forceinline__ f32x4 mfma16(bf16x8 a, bf16x8 b, f32x4 c) { return emu_mfma16(a, b, c); }
#else
__device__ __forceinline__ float u2f(unsigned u) { return __uint_as_float(u); }
__device__ __forceinline__ unsigned f2u(float f) { return __float_as_uint(f); }
#define SMEM_DECL unsigned char* smem = smem_base()
__device__ __forceinline__ f32x4 mfma16(bf16x8 a, bf16x8 b, f32x4 c) { return __builtin_amdgcn_mfma_f32_16x16x32_bf16(a, b, c, 0, 0, 0); }
#endif
__device__ __forceinline__ float bf2f(bf16_t h) { return u2f((unsigned)h << 16); }
#ifdef CPU_EMU
__device__ __forceinline__ bf16_t f2bf(float f) { unsigned u = f2u(f); u += 0x7fffu + ((u >> 16) & 1u); return (bf16_t)(u >> 16); }
__device__ __forceinline__ unsigned pack2(float lo, float hi) { return (unsigned)f2bf(lo) | ((unsigned)f2bf(hi) << 16); }
#else
typedef __bf16 bf16x2_hw __attribute__((ext_vector_type(2)));
typedef float f32x2_hw __attribute__((ext_vector_type(2)));
__device__ __forceinline__ unsigned pack2(float lo, float hi) { const f32x2_hw v = {lo, hi}; return __builtin_bit_cast(unsigned, __builtin_convertvector(v, bf16x2_hw)); }
__device__ __forceinline__ bf16_t f2bf(float f) { return (bf16_t)(pack2(f, f) & 0xffffu); }
#endif
__device__ __forceinline__ float bflo(unsigned u) { return u2f(u << 16); }
__device__ __forceinline__ float bfhi(unsigned u) { return u2f(u & 0xffff0000u); }
#ifdef CPU_EMU
__device__ __forceinline__ float fexp(float x) { return expf(x); }
#else
__device__ __forceinline__ float fexp(float x) { return __expf(x); }
#endif
__device__ __forceinline__ float sigmoidf_(float x) { return 1.f / (1.f + expf(-x)); }
__device__ __forceinline__ float siluf_(float x) { return x / (1.f + expf(-x)); }
__device__ __forceinline__ float ftanh(float x) { const float e = fexp(-2.f * fabsf(x)); const float t = (1.f - e) / (1.f + e); return x < 0.f ? -t : t; }
__device__ __forceinline__ float wave_sum(float v) {
#pragma unroll
    for (int m = 32; m >= 1; m >>= 1) v += __shfl_xor(v, m);
    return v;
}
__device__ __forceinline__ float wave_max(float v) {
#pragma unroll
    for (int m = 32; m >= 1; m >>= 1) v = fmaxf(v, __shfl_xor(v, m));
    return v;
}
#ifdef CPU_EMU
__device__ __forceinline__ float fp8_dec(unsigned b) {
    const unsigned s = b >> 7, e = (b >> 3) & 15, m = b & 7; float v;
    if (e == 0) v = ldexpf((float)m, -9); else v = ldexpf(1.f + m / 8.f, (int)e - 7);
    return s ? -v : v;
}
__device__ __forceinline__ unsigned fp8_enc(float f) {
    const unsigned s = f < 0.f ? 0x80u : 0u; float a = fabsf(f); if (!(a < 448.f)) return s | 0x7Eu;
    if (a < ldexpf(1.f, -6)) { const int q = (int)rintf(a * 512.f); return s | (unsigned)q; }
    int e; const float fr = frexpf(a, &e); e -= 1;
    int m = (int)rintf((2.f * fr - 1.f) * 8.f); if (m == 8) { m = 0; e += 1; }
    unsigned c = (unsigned)((e + 7) << 3) | (unsigned)m; if (c > 0x7Eu) c = 0x7Eu;
    return s | c;
}
__device__ __forceinline__ void fp8x16_dec(uint4 u, float* f) {
    const unsigned w[4] = {u.x, u.y, u.z, u.w};
    for (int i = 0; i < 16; ++i) f[i] = fp8_dec((w[i >> 2] >> (8 * (i & 3))) & 255u);
}
__device__ __forceinline__ uint4 fp8x16_enc(const float* f) {
    unsigned w[4] = {0, 0, 0, 0};
    for (int i = 0; i < 16; ++i) w[i >> 2] |= fp8_enc(f[i]) << (8 * (i & 3));
    return make_uint4(w[0], w[1], w[2], w[3]);
}
__device__ __forceinline__ float wave_sum_fast(float v) { return wave_sum(v); }
#else
typedef float f32x2_t __attribute__((ext_vector_type(2)));
__device__ __forceinline__ void fp8x4_dec(unsigned w, float* f) {
    const f32x2_t a = __builtin_amdgcn_cvt_pk_f32_fp8((int)w, false), b = __builtin_amdgcn_cvt_pk_f32_fp8((int)w, true);
    f[0] = a[0]; f[1] = a[1]; f[2] = b[0]; f[3] = b[1];
}
__device__ __forceinline__ void fp8x16_dec(uint4 u, float* f) { fp8x4_dec(u.x, f); fp8x4_dec(u.y, f + 4); fp8x4_dec(u.z, f + 8); fp8x4_dec(u.w, f + 12); }
__device__ __forceinline__ unsigned fp8x4_enc(const float* f) {
    int w = 0;
    w = __builtin_amdgcn_cvt_pk_fp8_f32(f[0], f[1], w, false);
    w = __builtin_amdgcn_cvt_pk_fp8_f32(f[2], f[3], w, true);
    return (unsigned)w;
}
__device__ __forceinline__ uint4 fp8x16_enc(const float* f) { return make_uint4(fp8x4_enc(f), fp8x4_enc(f + 4), fp8x4_enc(f + 8), fp8x4_enc(f + 12)); }
__device__ __forceinline__ float wave_sum_fast(float v) {
    v += __int_as_float(__builtin_amdgcn_update_dpp(0, __float_as_int(v), 0xB1, 0xF, 0xF, true));
    v += __int_as_float(__builtin_amdgcn_update_dpp(0, __float_as_int(v), 0x4E, 0xF, 0xF, true));
    v += __int_as_float(__builtin_amdgcn_update_dpp(0, __float_as_int(v), 0x141, 0xF, 0xF, true));
    v += __int_as_float(__builtin_amdgcn_update_dpp(0, __float_as_int(v), 0x140, 0xF, 0xF, true));
    v += __int_as_float(__builtin_amdgcn_update_dpp(0, __float_as_int(v), 0x142, 0xA, 0xF, false));
    v += __int_as_float(__builtin_amdgcn_update_dpp(0, __float_as_int(v), 0x143, 0xC, 0xF, false));
    return __int_as_float(__builtin_amdgcn_readlane(__float_as_int(v), 63));
}
#endif
__device__ __forceinline__ unsigned fp6_enc(float f) {
    const unsigned s = f < 0.f ? 32u : 0u; const float a = fminf(fabsf(f), 7.5f);
    float c;
    if (a < 2.f) c = rintf(a * 8.f);
    else if (a < 4.f) c = 16.f + rintf((a - 2.f) * 4.f);
    else c = 24.f + rintf((a - 4.f) * 2.f);
    unsigned code = (unsigned)c; if (code > 31u) code = 31u;
    return s | code;
}
typedef unsigned u32x6 __attribute__((ext_vector_type(6)));
typedef float f32x32 __attribute__((ext_vector_type(32)));
__device__ __forceinline__ void fp6x32_pack(const float* f, unsigned* w) {
#pragma unroll
    for (int k = 0; k < 6; ++k) w[k] = 0u;
#pragma unroll
    for (int i = 0; i < 32; ++i) { const unsigned c = fp6_enc(f[i]); const int bit = 6 * i, k = bit >> 5, sh = bit & 31; w[k] |= c << sh; if (sh > 26) w[k + 1] |= c >> (32 - sh); }
}
#ifdef CPU_EMU
__device__ __forceinline__ void fp6x32_dec(const unsigned* w, float* f) {
    for (int i = 0; i < 32; ++i) { const int bit = 6 * i, k = bit >> 5, sh = bit & 31; unsigned c = w[k] >> sh; if (sh > 26) c |= w[k + 1] << (32 - sh); c &= 63u;
        const unsigned e = (c >> 3) & 3u, m = c & 7u; const float v = e == 0 ? m * 0.125f : (1.f + m * 0.125f) * (float)(1 << (e - 1)); f[i] = (c & 32u) ? -v : v; }
}
#else
__device__ __forceinline__ void fp6x32_dec(const unsigned* w, float* f) {
    const u32x6 src = {w[0], w[1], w[2], w[3], w[4], w[5]};
    const f32x32 r = __builtin_amdgcn_cvt_scalef32_pk32_f32_fp6(src, 1.0f);
#pragma unroll
    for (int i = 0; i < 32; ++i) f[i] = r[i];
}
#endif
__device__ __forceinline__ void unpack8(uint4 u, float* f) {
    f[0] = bflo(u.x); f[1] = bfhi(u.x); f[2] = bflo(u.y); f[3] = bfhi(u.y); f[4] = bflo(u.z); f[5] = bfhi(u.z); f[6] = bflo(u.w); f[7] = bfhi(u.w);
}
__device__ __forceinline__ uint4 pack8(const float* f) { return make_uint4(pack2(f[0], f[1]), pack2(f[2], f[3]), pack2(f[4], f[5]), pack2(f[6], f[7])); }


#ifdef CPU_EMU
__device__ __forceinline__ unsigned char* smem_base() { return emu_smem(); }
#else
__device__ __forceinline__ unsigned char* smem_base() { extern __shared__ __attribute__((aligned(16))) unsigned char smem_dyn[]; return smem_dyn; }
#endif
struct KP {
    const Params* kp; unsigned char* ws; unsigned char* sm; int tid, bid, G;
    __device__ __forceinline__ const float* in(int i) const { return kp->in[i]; }
    __device__ __forceinline__ float* out() const { return kp->out; }
};
__device__ __forceinline__ KP fresh(const Params& kp) {
    KP r; r.kp = &kp; r.ws = kp.ws; r.sm = smem_base();
    r.tid = threadIdx.x; r.bid = blockIdx.x; r.G = gridDim.x;
#ifndef CPU_EMU
    asm volatile("" : "+v"(r.tid)); asm volatile("" : "+s"(r.bid)); asm volatile("" : "+s"(r.G));
    { size_t zero = 0; asm volatile("" : "+s"(zero)); r.ws = kp.ws + zero; }
#endif
    return r;
}
#ifdef CPU_EMU
struct GridBar { int dummy; };
__device__ __forceinline__ GridBar gridbar_init(unsigned*, unsigned char*) { return GridBar{0}; }
__device__ __forceinline__ void grid_sync(const Params&) { emu_gridsync(); }
#else
#define XB_TMO      128
#define XB_XCNT(j)  (256  + 64 * (j))
#define XB_XSUB(j)  (1280 + 64 * (j))
#define XB_XGEN(j)  (2304 + 64 * (j))
#define XB_TOP      3328
#define XB_TOPGEN   3392
#define XCD_BAR_WORDS 3456
#define XB_SPIN_CAP (1u << 28)
#define LAS __attribute__((address_space(3)))
__device__ __forceinline__ unsigned xb_ld(unsigned* p) { return __hip_atomic_load(p, __ATOMIC_RELAXED, __HIP_MEMORY_SCOPE_AGENT); }
__device__ __forceinline__ unsigned xb_add(unsigned* p, unsigned v) { return __hip_atomic_fetch_add(p, v, __ATOMIC_RELAXED, __HIP_MEMORY_SCOPE_AGENT); }
__device__ __forceinline__ unsigned xb_xcc_id() { return (unsigned)__builtin_amdgcn_s_getreg((3 << 11) | 20) & 0xFu; }
#define XB_SPIN(cond, bar) do { unsigned _sp = 0; while (cond) { __builtin_amdgcn_s_sleep(1); \
    if ((++_sp & 255u) == 0u) { if (xb_ld(&(bar)[XB_TMO])) break; if (_sp > XB_SPIN_CAP) { atomicAdd(&(bar)[XB_TMO], 1u); break; } } } } while (0)
struct GridBar { unsigned* bar; unsigned x; volatile LAS unsigned* st; };
__device__ __forceinline__ GridBar gridbar_init(unsigned* bar, unsigned char* smem_words) {
    GridBar b; b.bar = bar; b.x = xb_xcc_id(); b.st = (volatile LAS unsigned*)smem_words;
    if (threadIdx.x == 0) { b.st[0] = 0u; b.st[1] = 0u; (void)xb_add(&bar[XB_XCNT(b.x)], 1u); }
    __syncthreads();
    return b;
}
__device__ __forceinline__ void xcd_barrier_complete(unsigned* bar, unsigned x, unsigned& nloc, unsigned& nx) {
    const unsigned G = gridDim.x;
    unsigned sum, cnt, mine, sp = 0u;
    for (;;) {
        sum = 0u; cnt = 0u; mine = 0u;
#pragma unroll
        for (unsigned j = 0; j < 16; ++j) { const unsigned c = xb_ld(&bar[XB_XCNT(j)]); sum += c; cnt += (c > 0u) ? 1u : 0u; mine = (j == x) ? c : mine; }
        if (sum == G) break;
        __builtin_amdgcn_s_sleep(1);
        if ((++sp & 255u) == 0u) { if (xb_ld(&bar[XB_TMO])) break; if (sp > XB_SPIN_CAP) { atomicAdd(&bar[XB_TMO], 1u); break; } }
    }
    nloc = mine > 0u ? mine : 1u; nx = cnt > 0u ? cnt : 1u;
}
__device__ __forceinline__ void grid_sync(const Params& kp_) {
    GridBar b; b.bar = (unsigned*)(kp_.ws + O_BAR); b.x = xb_xcc_id(); b.st = (volatile LAS unsigned*)(smem_base() + LDS_BYTES - 16);
#if USE_CG_SYNC
    cooperative_groups::this_grid().sync();
    return;
#endif
    asm volatile("s_waitcnt vmcnt(0)" ::: "memory");
    __syncthreads();
    if (threadIdx.x == 0) {
        unsigned* bar = b.bar;
        __builtin_amdgcn_s_waitcnt(0);
        unsigned nloc = b.st[0], nx = b.st[1];
        if (nloc == 0u) { xcd_barrier_complete(bar, b.x, nloc, nx); b.st[0] = nloc; b.st[1] = nx; }
        const unsigned old = xb_add(&bar[XB_XSUB(b.x)], 1u);
        const unsigned gen = old / nloc;
        if (old + 1u == (gen + 1u) * nloc) {
            __builtin_amdgcn_fence(__ATOMIC_RELEASE, "agent");
            asm volatile("s_waitcnt vmcnt(0)" ::: "memory");
            const unsigned og = xb_add(&bar[XB_TOP], 1u);
            const unsigned tg = og / nx;
            if (og + 1u == (tg + 1u) * nx) xb_add(&bar[XB_TOPGEN], 1u);
            else XB_SPIN(xb_ld(&bar[XB_TOPGEN]) == tg, bar);
            __builtin_amdgcn_fence(__ATOMIC_ACQUIRE, "agent");
            xb_add(&bar[XB_XGEN(b.x)], 1u);
            asm volatile("s_waitcnt vmcnt(0)" ::: "memory");
        } else {
            XB_SPIN(xb_ld(&bar[XB_XGEN(b.x)]) == gen, bar);
            __builtin_amdgcn_fence(__ATOMIC_ACQUIRE, "agent");
            asm volatile("s_waitcnt vmcnt(0)" ::: "memory");
        }
    }
    __syncthreads();
}
#endif

#ifdef CPU_EMU
#define LDS_BARRIER() __syncthreads()
#else
#define LDS_BARRIER() do { asm volatile("s_waitcnt lgkmcnt(0)" ::: "memory"); __builtin_amdgcn_s_barrier(); asm volatile("" ::: "memory"); } while (0)
#endif
constexpr int LSTR = 72;
struct Seg { const bf16_t* A; long lda; const bf16_t* B; long ldb; int K; };
__device__ __forceinline__ void gemm_core(const int tid, const Seg& s0, const Seg& s1, const Seg& s2, unsigned char* smem, f32x4 (&acc)[4][2]) {
    const int lane = tid & 63, wid = tid >> 6, wm = wid >> 2, wn = wid & 3;
    bf16_t* sA = (bf16_t*)smem; bf16_t* sB = sA + 128 * LSTR;
    const int lr = tid >> 3, lc = (tid & 7) * 8;
#pragma unroll
    for (int i = 0; i < 4; ++i)
#pragma unroll
        for (int j = 0; j < 2; ++j) acc[i][j] = (f32x4){0.f, 0.f, 0.f, 0.f};
    const int nsteps = (s0.K + s1.K + s2.K) >> 6;
    uint4 ra0, ra1, rb0, rb1;
    auto gload = [&](int s) {
        int kk = s * 64; const bf16_t* Ap; const bf16_t* Bp; long la, lb;
        if (kk < s0.K) { Ap = s0.A + kk; Bp = s0.B + kk; la = s0.lda; lb = s0.ldb; }
        else if (kk < s0.K + s1.K) { kk -= s0.K; Ap = s1.A + kk; Bp = s1.B + kk; la = s1.lda; lb = s1.ldb; }
        else { kk -= s0.K + s1.K; Ap = s2.A + kk; Bp = s2.B + kk; la = s2.lda; lb = s2.ldb; }
        ra0 = *(const uint4*)(Ap + (long)lr * la + lc); ra1 = *(const uint4*)(Ap + (long)(lr + 64) * la + lc);
        rb0 = *(const uint4*)(Bp + (long)lr * lb + lc); rb1 = *(const uint4*)(Bp + (long)(lr + 64) * lb + lc);
    };
    gload(0);
    for (int s = 0; s < nsteps; ++s) {
        LDS_BARRIER();
        *(uint4*)(sA + lr * LSTR + lc) = ra0; *(uint4*)(sA + (lr + 64) * LSTR + lc) = ra1;
        *(uint4*)(sB + lr * LSTR + lc) = rb0; *(uint4*)(sB + (lr + 64) * LSTR + lc) = rb1;
        LDS_BARRIER();
        if (s + 1 < nsteps) gload(s + 1);
#pragma unroll
        for (int ks = 0; ks < 2; ++ks) {
            bf16x8 af[4], bfr[2];
#pragma unroll
            for (int mt = 0; mt < 4; ++mt) af[mt] = *(const bf16x8*)(sA + (wm * 64 + mt * 16 + (lane & 15)) * LSTR + ks * 32 + (lane >> 4) * 8);
#pragma unroll
            for (int nt = 0; nt < 2; ++nt) bfr[nt] = *(const bf16x8*)(sB + (wn * 32 + nt * 16 + (lane & 15)) * LSTR + ks * 32 + (lane >> 4) * 8);
#pragma unroll
            for (int mt = 0; mt < 4; ++mt)
#pragma unroll
                for (int nt = 0; nt < 2; ++nt) acc[mt][nt] = mfma16(bfr[nt], af[mt], acc[mt][nt]);
        }
    }
    LDS_BARRIER();
}
#define ACC_FOREACH(...) { const int _lane = p.tid & 63, _wid = p.tid >> 6, _wm = _wid >> 2, _wn = _wid & 3; \
    _Pragma("unroll") for (int _mt = 0; _mt < 4; ++_mt) _Pragma("unroll") for (int _nt = 0; _nt < 2; ++_nt) { \
        const int m = _wm * 64 + _mt * 16 + (_lane & 15), n = _wn * 32 + _nt * 16 + (_lane >> 4) * 4; const f32x4 v = acc[_mt][_nt]; __VA_ARGS__ } }
__device__ __forceinline__ Seg mkseg(const bf16_t* A, long lda, const bf16_t* B, long ldb, int K) { Seg s; s.A = A; s.lda = lda; s.B = B; s.ldb = ldb; s.K = K; return s; }
__device__ __forceinline__ void st_bf4(bf16_t* p, float a, float b, float c, float d) { *(uint2*)p = make_uint2(pack2(a, b), pack2(c, d)); }
__device__ __forceinline__ void st_f4(float* p, float a, float b, float c, float d) { *(float4*)p = make_float4(a, b, c, d); }

#ifdef CPU_EMU
#define PG8_LAS
#define PG8_GLDS(src, dst) memcpy((unsigned char*)(dst) + (threadIdx.x & 63) * 16, (const void*)(src), 16)
#define PG8_RFL(x) (x)
#define PG8_WAIT_V(n)
#define PG8_WAIT_L(n)
#define PG8_BAR __syncthreads()
#define PG8_SCHED
#define PG8_PRIO(x)
#else
#define PG8_LAS __attribute__((address_space(3)))
#define PG8_GLDS(src, dst) __builtin_amdgcn_global_load_lds((const unsigned*)(src), (PG8_LAS unsigned*)(dst), 16, 0, 0)
#define PG8_RFL(x) __builtin_amdgcn_readfirstlane(x)
#define PG8_WAIT_V(n) asm volatile("s_waitcnt vmcnt(" #n ")" ::: "memory")
#define PG8_WAIT_L(n) asm volatile("s_waitcnt lgkmcnt(" #n ")" ::: "memory")
#define PG8_BAR __builtin_amdgcn_s_barrier()
#define PG8_SCHED __builtin_amdgcn_sched_barrier(0)
#define PG8_PRIO(x) __builtin_amdgcn_s_setprio(x)
#endif
namespace pg8 {
constexpr int BM = 256, BK = 64, HALF = 128, HTB = HALF * BK * 2, NXCD = 8, WGM = 8;
__device__ __forceinline__ int lds_byte(int r, int c) { const int st = (r >> 4) * 2 + (c >> 5), rr = r & 15, cc = c & 31, ob = rr * 64 + cc * 2; return st * 1024 + (ob ^ (((ob >> 9) & 1) << 5)); }
__device__ __forceinline__ void stage_rc(int b, int& R, int& C) { const int st = b / 1024, sb = b % 1024, swz = sb ^ (((sb >> 9) & 1) << 5); R = (st >> 1) * 16 + swz / 64; C = (st & 1) * 32 + (swz % 64) / 2; }
struct Unit { int pm, pn; };
struct Gemm { const bf16_t* A; const bf16_t* Bt; int M, N, K; };
struct StaticOrder {
    int nM, nN, nwg, G, c;
    __device__ __forceinline__ void init(int M, int N, int G_, int c_) { nM = M / BM; nN = N / BM; nwg = nM * nN; G = G_; c = c_; }
    __device__ __forceinline__ bool next(int i, Unit& u) const {
        const long L = (long)i * G + c; if (L >= nwg) return false;
        int wgid = (int)L; { const int q = nwg / NXCD, r = nwg % NXCD, xcd = wgid % NXCD, off = wgid / NXCD; wgid = (xcd < r ? xcd * (q + 1) : r * (q + 1) + (xcd - r) * q) + off; }
        const int nig = WGM * nN, gid = wgid / nig, fm = gid * WGM, gsz = (nM - fm) < WGM ? (nM - fm) : WGM;
        u.pm = fm + ((wgid % nig) % gsz); u.pn = (wgid % nig) / gsz; return true;
    }
};
template <class Epi>
__device__ __forceinline__ void gemm_phase(PG8_LAS unsigned char* lds, const int tid, const Gemm g, const StaticOrder& S, const Epi& E) {
    const int wid = PG8_RFL(tid >> 6), lane = tid & 63, wr = wid >> 2, wc = wid & 3, fr = lane & 15, fq = lane >> 4;
    const int K = g.K, nt = K / BK;
    unsigned voffA[2];
#pragma unroll
    for (int i = 0; i < 2; ++i) { int R, C; stage_rc(tid * 16 + i * 8192, R, C); voffA[i] = (unsigned)(R * K + C) * 2u; }
    const size_t kstep = (size_t)(BK * 2), hstep = (size_t)HALF * K * 2, tstep = 2 * hstep;
    const unsigned ldsw = (unsigned)wid * 1024u;
    const int aoff = lds_byte(wr * 64 + fr, fq * 8), boff = lds_byte(wc * 32 + fr, fq * 8);
#define PG8_SA(b, h) (((b) * 2 + (h)) * HTB)
#define PG8_SB(b, h) ((4 + (b) * 2 + (h)) * HTB)
#define PG8_STAGE(bufoff, gbase) do { _Pragma("unroll") for (int _i = 0; _i < 2; ++_i) PG8_GLDS((const char*)(gbase) + voffA[_i], lds + (bufoff) + ldsw + _i * 8192); } while (0)
#define PG8_LDA(dst, b, h) do { _Pragma("unroll") for (int m = 0; m < 4; ++m) _Pragma("unroll") for (int k = 0; k < 2; ++k) dst[m][k] = *(const PG8_LAS bf16x8*)(lds + PG8_SA(b, h) + aoff + m * 2048 + k * 1024); } while (0)
#define PG8_LDB(dst, b, h) do { _Pragma("unroll") for (int n = 0; n < 2; ++n) _Pragma("unroll") for (int k = 0; k < 2; ++k) dst[n][k] = *(const PG8_LAS bf16x8*)(lds + PG8_SB(b, h) + boff + n * 2048 + k * 1024); } while (0)
#define PG8_MMA(ai, bj, At, Bt) do { PG8_PRIO(1); _Pragma("unroll") for (int m = 0; m < 4; ++m) _Pragma("unroll") for (int n = 0; n < 2; ++n) _Pragma("unroll") for (int k = 0; k < 2; ++k) \
        acc[ai][bj][m][n] = mfma16(Bt[n][k], At[m][k], acc[ai][bj][m][n]); PG8_PRIO(0); } while (0)
    Unit cur, nxt; int ui = 0;
    if (!S.next(0, cur)) return;
    f32x4 acc[2][2][4][2];
#pragma unroll
    for (int a = 0; a < 2; ++a)
#pragma unroll
        for (int b = 0; b < 2; ++b)
#pragma unroll
            for (int m = 0; m < 4; ++m)
#pragma unroll
                for (int n = 0; n < 2; ++n) acc[a][b][m][n] = (f32x4){0.f, 0.f, 0.f, 0.f};
    bf16x8 At[4][2], B0[2][2], B1[2][2];
    const char* cA = (const char*)g.A + (size_t)cur.pm * tstep; const char* cB = (const char*)g.Bt + (size_t)cur.pn * tstep;
    PG8_STAGE(PG8_SB(0, 0), cB); PG8_STAGE(PG8_SA(0, 0), cA); PG8_STAGE(PG8_SB(0, 1), cB + hstep); PG8_STAGE(PG8_SA(0, 1), cA + hstep);
    if (wr == 1) PG8_BAR;
    PG8_WAIT_V(4); PG8_BAR;
    PG8_STAGE(PG8_SB(1, 0), cB + kstep); PG8_STAGE(PG8_SA(1, 0), cA + kstep); PG8_STAGE(PG8_SB(1, 1), cB + hstep + kstep);
    PG8_WAIT_V(6); PG8_BAR;
    for (;;) {
        const bool has_next = S.next(ui + 1, nxt);
        const char* nA = has_next ? (const char*)g.A + (size_t)nxt.pm * tstep : cA; const char* nB = has_next ? (const char*)g.Bt + (size_t)nxt.pn * tstep : cB;
        for (int t = 0; t < nt; t += 2) {
            const bool last = (t == nt - 2);
            const char* a1 = cA + (size_t)(t + 1) * kstep;
            const char* a2 = last ? nA : cA + (size_t)(t + 2) * kstep; const char* b2 = last ? nB : cB + (size_t)(t + 2) * kstep;
            const char* a3 = a2 + kstep; const char* b3 = b2 + kstep;
            PG8_LDB(B0, 0, 0); PG8_SCHED; PG8_LDA(At, 0, 0); PG8_STAGE(PG8_SA(1, 1), a1 + hstep);
            PG8_WAIT_L(8); PG8_BAR; PG8_WAIT_L(0); PG8_MMA(0, 0, At, B0); PG8_BAR; PG8_SCHED;
            PG8_LDB(B1, 0, 1); PG8_STAGE(PG8_SB(0, 0), b2);
            PG8_BAR; PG8_WAIT_L(0); PG8_MMA(0, 1, At, B1); PG8_BAR;
            PG8_LDA(At, 0, 1); PG8_STAGE(PG8_SA(0, 0), a2);
            PG8_BAR; PG8_WAIT_L(0); PG8_MMA(1, 0, At, B0); PG8_BAR; PG8_SCHED;
            PG8_STAGE(PG8_SB(0, 1), b2 + hstep);
            PG8_WAIT_V(6); PG8_BAR; PG8_MMA(1, 1, At, B1); PG8_BAR;
            PG8_LDB(B0, 1, 0); PG8_SCHED; PG8_LDA(At, 1, 0); PG8_STAGE(PG8_SA(0, 1), a2 + hstep);
            PG8_WAIT_L(8); PG8_BAR; PG8_WAIT_L(0); PG8_MMA(0, 0, At, B0); PG8_BAR; PG8_SCHED;
            PG8_LDB(B1, 1, 1); PG8_STAGE(PG8_SB(1, 0), b3);
            PG8_BAR; PG8_WAIT_L(0); PG8_MMA(0, 1, At, B1); PG8_BAR;
            PG8_LDA(At, 1, 1); PG8_STAGE(PG8_SA(1, 0), a3);
            PG8_BAR; PG8_WAIT_L(0); PG8_MMA(1, 0, At, B0); PG8_BAR; PG8_SCHED;
            PG8_STAGE(PG8_SB(1, 1), b3 + hstep);
            PG8_WAIT_V(6); PG8_BAR; PG8_MMA(1, 1, At, B1); PG8_BAR;
        }
        E(acc, cur, wr, wc, fr, fq);
        if (!has_next) break;
#pragma unroll
        for (int a = 0; a < 2; ++a)
#pragma unroll
            for (int b = 0; b < 2; ++b)
#pragma unroll
                for (int m = 0; m < 4; ++m)
#pragma unroll
                    for (int n = 0; n < 2; ++n) acc[a][b][m][n] = (f32x4){0.f, 0.f, 0.f, 0.f};
        cur = nxt; cA = nA; cB = nB; ++ui;
    }
    PG8_WAIT_V(0);
    if (wr == 0) PG8_BAR;
    PG8_BAR;
#undef PG8_SA
#undef PG8_SB
#undef PG8_STAGE
#undef PG8_LDA
#undef PG8_LDB
#undef PG8_MMA
}
template <class F> struct EpiFn {
    F f;
    __device__ __forceinline__ void operator()(const f32x4 (&acc)[2][2][4][2], const Unit& u, int wr, int wc, int fr, int fq) const {
#pragma unroll
        for (int ai = 0; ai < 2; ++ai)
#pragma unroll
            for (int m = 0; m < 4; ++m)
#pragma unroll
                for (int bj = 0; bj < 2; ++bj)
#pragma unroll
                    for (int n = 0; n < 2; ++n) f(u.pm * BM + ai * HALF + wr * 64 + m * 16 + fr, u.pn * BM + bj * HALF + wc * 32 + n * 16 + 4 * fq, acc[ai][bj][m][n]);
    }
};
}
template <class F>
__device__ __forceinline__ void big_gemm_lat(const KP& p, unsigned char* smem, const bf16_t* A, const bf16_t* W, int N, F f) {
    pg8::Gemm g; g.A = A + (size_t)CTX * D; g.Bt = W; g.M = SEQ; g.N = N; g.K = D;
    pg8::StaticOrder S; S.init(SEQ, N, p.G, p.bid);
    auto f2 = [&](int r, int c, const f32x4& v) { f(r + CTX, c, v); };
    pg8::EpiFn<decltype(f2)> E{f2};
    pg8::gemm_phase((PG8_LAS unsigned char*)smem, p.tid, g, S, E);
}
template <class F>
__device__ __forceinline__ void ctx_gemm(const KP& p, unsigned char* smem, const bf16_t* A, const bf16_t* W, int N, int rot, F f) {
    const int tid = p.tid, lane = tid & 63, wid = tid >> 6, l15 = lane & 15, g = lane >> 4;
    float* red = (float*)smem;
    const int nitems = (CTX / 16) * (N / 64);
    for (int it = (p.bid + p.G - rot % p.G) % p.G; it < nitems; it += p.G) {
        const int m0 = (it % (CTX / 16)) * 16, n0 = (it / (CTX / 16)) * 64;
        const bf16_t* ap = A + (size_t)(m0 + l15) * D + wid * 128 + g * 8;
        const bf16_t* bp = W + (size_t)(n0 + l15) * D + wid * 128 + g * 8;
        bf16x8 af[4], bfr[4][4];
#pragma unroll
        for (int ks = 0; ks < 4; ++ks) {
            af[ks] = *(const bf16x8*)(ap + ks * 32);
#pragma unroll
            for (int nt = 0; nt < 4; ++nt) bfr[nt][ks] = *(const bf16x8*)(bp + (size_t)nt * 16 * D + ks * 32);
        }
        LDS_BARRIER();
#pragma unroll
        for (int nt = 0; nt < 4; ++nt) {
            f32x4 acc = {0.f, 0.f, 0.f, 0.f};
#pragma unroll
            for (int ks = 0; ks < 4; ++ks) acc = mfma16(bfr[nt][ks], af[ks], acc);
            *(float4*)(red + ((wid * 4 + nt) * 64 + lane) * 4) = make_float4(acc[0], acc[1], acc[2], acc[3]);
        }
        LDS_BARRIER();
        if (tid < 256) {
            const int nt = tid >> 6;
            float4 sum = *(const float4*)(red + (nt * 64 + lane) * 4);
#pragma unroll
            for (int w = 1; w < 8; ++w) { const float4 t = *(const float4*)(red + ((w * 4 + nt) * 64 + lane) * 4); sum.x += t.x; sum.y += t.y; sum.z += t.z; sum.w += t.w; }
            f(m0 + l15, n0 + nt * 16 + g * 4, (f32x4){sum.x, sum.y, sum.z, sum.w});
        }
    }
    LDS_BARRIER();
}
template <class F>
__device__ __forceinline__ void big_gemm(const KP& p, unsigned char* smem, const bf16_t* A, const bf16_t* W, int N, bool with_ctx, F f) {
    big_gemm_lat(p, smem, A, W, N, f);
    if (with_ctx) ctx_gemm(p, smem, A, W, N, 0, f);
}

template <int L = 0> __device__ __forceinline__ void row_ld(float* v, const float* p, int lane) {
    const float* q0 = L ? p + lane * 16 : p + lane * 8; const float* q1 = L ? p + lane * 16 + 8 : p + 512 + lane * 8;
    const float4 a = *(const float4*)q0, b = *(const float4*)(q0 + 4), c = *(const float4*)q1, d = *(const float4*)(q1 + 4);
    v[0] = a.x; v[1] = a.y; v[2] = a.z; v[3] = a.w; v[4] = b.x; v[5] = b.y; v[6] = b.z; v[7] = b.w;
    v[8] = c.x; v[9] = c.y; v[10] = c.z; v[11] = c.w; v[12] = d.x; v[13] = d.y; v[14] = d.z; v[15] = d.w;
}
template <int L = 0> __device__ __forceinline__ void row_st(float* p, const float* v, int lane) {
    float* q0 = L ? p + lane * 16 : p + lane * 8; float* q1 = L ? p + lane * 16 + 8 : p + 512 + lane * 8;
    *(float4*)q0 = make_float4(v[0], v[1], v[2], v[3]); *(float4*)(q0 + 4) = make_float4(v[4], v[5], v[6], v[7]);
    *(float4*)q1 = make_float4(v[8], v[9], v[10], v[11]); *(float4*)(q1 + 4) = make_float4(v[12], v[13], v[14], v[15]);
}
__device__ __forceinline__ void row_ld_bf(float* v, const bf16_t* p, int lane) {
    unpack8(*(const uint4*)(p + lane * 8), v); unpack8(*(const uint4*)(p + 512 + lane * 8), v + 8);
}
template <int L = 0> __device__ __forceinline__ void row_st_bf(bf16_t* p, const float* v, int lane) {
    *(uint4*)(L ? p + lane * 16 : p + lane * 8) = pack8(v); *(uint4*)(L ? p + lane * 16 + 8 : p + 512 + lane * 8) = pack8(v + 8);
}
template <int L = 0> __device__ __forceinline__ void row_layernorm(float* v, const float* g, const float* b, int lane) {
    float s = 0.f;
#pragma unroll
    for (int i = 0; i < 16; ++i) s += v[i];
    const float mu = wave_sum(s) * (1.f / 1024.f);
    float q = 0.f;
#pragma unroll
    for (int i = 0; i < 16; ++i) { const float d = v[i] - mu; q += d * d; }
    const float rs = rsqrtf(wave_sum(q) * (1.f / 1024.f) + 1e-5f);
    float gg[16], bb[16]; row_ld<L>(gg, g, lane); row_ld<L>(bb, b, lane);
#pragma unroll
    for (int i = 0; i < 16; ++i) v[i] = (v[i] - mu) * rs * gg[i] + bb[i];
}
__device__ __forceinline__ const float* modp(const KP& p, int layer, int tok, int part) {
    return (const float*)(p.ws + O_MOD) + ((size_t)(layer * 2 + (tok < CTX ? 1 : 0)) * 6 + part) * 1024;
}
template <int L = 0> __device__ __forceinline__ void emit_layer_input(const KP& p, int layer, int tok, const float* x, int lane) {
    if (layer >= DEPTH || (layer & 1)) return;
    float sh[16], sc[16], h[16];
    row_ld<L>(sh, modp(p, layer, tok, 0), lane); row_ld<L>(sc, modp(p, layer, tok, 1), lane);
#pragma unroll
    for (int i = 0; i < 16; ++i) h[i] = x[i] * (1.f + sc[i]) + sh[i];
    row_st_bf<L>((bf16_t*)(p.ws + O_HB) + (size_t)tok * D, h, lane);
}

__device__ __forceinline__ void cvt_transpose(const KP& p, const float* src, int K, int N, int ld_src, bf16_t* dst, int Kp, int Np, unsigned char* smem, int& base) {
    float* tile = (float*)smem;
    const int ntk = Kp / 64, ntn = Np / 64, nt = ntk * ntn, G = p.G, tid = p.tid;
    for (int t = ((int)p.bid - base % G + G) % G; t < nt; t += G) {
        const int k0 = (t / ntn) * 64, n0 = (t % ntn) * 64;
        { const int kl = tid >> 3, n8 = (tid & 7) * 8;
#pragma unroll
          for (int j = 0; j < 8; ++j) tile[kl * 65 + n8 + j] = 0.f;
          const int k = k0 + kl;
          if (k < K && n0 + n8 + 8 <= N && (ld_src & 3) == 0) {
              const float4 a = *(const float4*)(src + (size_t)k * ld_src + n0 + n8), b = *(const float4*)(src + (size_t)k * ld_src + n0 + n8 + 4);
              float* tp = tile + kl * 65 + n8; tp[0] = a.x; tp[1] = a.y; tp[2] = a.z; tp[3] = a.w; tp[4] = b.x; tp[5] = b.y; tp[6] = b.z; tp[7] = b.w;
          } else if (k < K) {
#pragma unroll
              for (int j = 0; j < 8; ++j) { const int n = n0 + n8 + j; if (n < N) tile[kl * 65 + n8 + j] = src[(size_t)k * ld_src + n]; }
          } }
        __syncthreads();
        { const int nl = tid >> 3, k8 = (tid & 7) * 8; float f[8];
#pragma unroll
          for (int j = 0; j < 8; ++j) f[j] = tile[(k8 + j) * 65 + nl];
          *(uint4*)(dst + (size_t)(n0 + nl) * Kp + k0 + k8) = pack8(f); }
        __syncthreads();
    }
    base += nt;
}
__device__ __forceinline__ void phase_setup(const Params& p_, unsigned char* smem) { const KP p = fresh(p_);
    const int G = p.G, bid = p.bid, tid = p.tid;
    unsigned char* ws = p.ws;
    int base = 0;
    for (int j = 0; j < NA; ++j) {
        cvt_transpose(p, p.in(8) + (size_t)j * 1024 * MPROJ, 1024, 4096, MPROJ, (bf16_t*)(ws + O_WIN) + (size_t)j * 4096 * 1024, 1024, 4096, smem, base);
        cvt_transpose(p, p.in(13) + (size_t)j * 1024 * 1024, 1024, 1024, 1024, (bf16_t*)(ws + O_WOUTM) + (size_t)j * 1024 * 1024, 1024, 1024, smem, base);
    }
    for (int j = 0; j < NB; ++j) {
        for (int n = 0; n < 3; ++n) cvt_transpose(p, p.in(15) + (size_t)(j * 3 + n) * 1024 * 1024, 1024, 1024, 1024, (bf16_t*)(ws + O_WRKV) + (size_t)(j * 3 + n) * 1024 * 1024, 1024, 1024, smem, base);
        for (int z = 0; z < 2; ++z) {
            cvt_transpose(p, p.in(17) + (size_t)(j * 2 + z) * 1024 * 64, 1024, 64, 64, (bf16_t*)(ws + O_W1C) + (size_t)(j * 128 + z * 64) * 1024, 1024, 64, smem, base);
            cvt_transpose(p, p.in(20) + (size_t)(j * 2 + z) * 1024 * 64, 1024, 64, 64, (bf16_t*)(ws + O_A1C) + (size_t)(j * 128 + z * 64) * 1024, 1024, 64, smem, base);
            cvt_transpose(p, p.in(18) + (size_t)(j * 2 + z) * 64 * 1024, 64, 1024, 1024, (bf16_t*)(ws + O_W2) + (size_t)(j * 2 + z) * 1024 * 64, 64, 1024, smem, base);
            cvt_transpose(p, p.in(21) + (size_t)(j * 2 + z) * 64 * 1024, 64, 1024, 1024, (bf16_t*)(ws + O_A2) + (size_t)(j * 2 + z) * 1024 * 64, 64, 1024, smem, base);
        }
        cvt_transpose(p, p.in(22) + (size_t)j * 1024 * 160, 1024, 160, 160, (bf16_t*)(ws + O_G1) + (size_t)j * 256 * 1024, 1024, 256, smem, base);
        cvt_transpose(p, p.in(23) + (size_t)j * 160 * 1024, 160, 1024, 1024, (bf16_t*)(ws + O_G2) + (size_t)j * 1024 * 192, 192, 1024, smem, base);
        cvt_transpose(p, p.in(29) + (size_t)j * 1024 * 1024, 1024, 1024, 1024, (bf16_t*)(ws + O_WOUTR) + (size_t)j * 1024 * 1024, 1024, 1024, smem, base);
    }
    for (int i = 0; i < DEPTH; ++i)
        cvt_transpose(p, p.in(30) + (size_t)i * 1024 * 2048, 1024, 2048, 2048, (bf16_t*)(ws + O_WQ) + (size_t)i * 2048 * 1024, 1024, 2048, smem, base);
    const size_t gtid = (size_t)bid * NT + tid, gstride = (size_t)G * NT;
    { const float* src = p.in(31); bf16_t* dst = (bf16_t*)(ws + O_KEYS);
      for (size_t i = gtid; i < (size_t)DEPTH * 16 * 128 * 128; i += gstride) dst[i] = f2bf(src[i]); }
    { float* dst = (float*)(ws + O_WING);
      for (size_t i = gtid; i < (size_t)NA * 16 * 1024; i += gstride) { const int k = i & 1023, g = (i >> 10) & 15, j = (int)(i >> 14); dst[i] = p.in(8)[((size_t)j * 1024 + k) * MPROJ + 4096 + g]; } }
    { bf16_t* dstb = (bf16_t*)(ws + O_WINGB);
      for (size_t i = gtid; i < (size_t)NA * 128 * 1024; i += gstride) { const int k = i & 1023, g = (i >> 10) & 127, j = (int)(i >> 17); dstb[i] = g < 16 ? f2bf(p.in(8)[((size_t)j * 1024 + k) * MPROJ + 4096 + g]) : (bf16_t)0; } }
    { bf16_t* dstc = (bf16_t*)(ws + O_CROW);
      for (size_t i = gtid; i < (size_t)DEPTH * 2048; i += gstride) { const int e = i & 1023, w = (i >> 10) & 1, l = (int)(i >> 11); dstc[((size_t)l * 4 + 2 + w) * 1024 + e] = f2bf((w ? p.in(7) : p.in(6))[(size_t)(l * 2 + 1) * D + e]); } }
    { float4* dst = (float4*)(ws + O_XS); const float4* c4 = (const float4*)p.in(2); const float4* x4 = (const float4*)p.in(0);
      for (size_t i = gtid; i < (size_t)T * 256; i += gstride) dst[i] = i < (size_t)CTX * 256 ? c4[i] : x4[i - (size_t)CTX * 256]; }
    { float* red = (float*)smem;
      float* ssil = red + 1024;
      for (int k = tid; k < 2048; k += NT) ssil[k] = siluf_(k < 1024 ? p.in(1)[k] : p.in(3)[k - 1024]);
      __syncthreads();
      const int lane = tid & 63, w = tid >> 6;
      for (int it = bid; it < DEPTH * 96; it += G) {
          const int layer = it / 96, col = (it % 96) * 64 + lane;
          const float* W = p.in(4) + (size_t)layer * 1024 * 6144;
          float a0 = 0.f, a1 = 0.f;
          for (int k = w * 128; k < w * 128 + 128; ++k) { const float wv = W[(size_t)k * 6144 + col]; a0 += ssil[k] * wv; a1 += ssil[1024 + k] * wv; }
          red[(w * 2 + 0) * 64 + lane] = a0; red[(w * 2 + 1) * 64 + lane] = a1;
          __syncthreads();
          if (tid < 128) { const int s = tid >> 6; float acc = 0.f;
#pragma unroll
              for (int ww = 0; ww < 8; ++ww) acc += red[(ww * 2 + s) * 64 + lane];
              const float mv_ = acc + p.in(5)[(size_t)layer * 6144 + col]; ((float*)(ws + O_MOD))[((size_t)layer * 2 + s) * 6144 + col] = mv_;
              if (col >= 5120) ((bf16_t*)(ws + O_CROW))[((size_t)layer * 4 + s) * 1024 + (col - 5120)] = f2bf(mv_); }
          __syncthreads();
      } }
}
__device__ __forceinline__ void phase_emit0(const Params& p_) { const KP p = fresh(p_);
    const int lane = p.tid & 63, gw = p.bid * 8 + (p.tid >> 6), nw = p.G * 8;
    for (int tok = gw; tok < T; tok += nw) { float x[16]; row_ld(x, (const float*)(p.ws + O_XS) + (size_t)tok * D, lane); emit_layer_input(p, 0, tok, x, lane); }
}
#if PEER_FP6
__device__ __forceinline__ void convert_peer_tables(const KP& p, int layer, int wg0 = 0, int nwg = 0) {
    if (nwg == 0) nwg = p.G;
    if (p.bid < wg0) return;
    const int lane = p.tid & 63, l31 = lane & 31, half = lane >> 5, gw = (p.bid - wg0) * 8 + (p.tid >> 6), nw = nwg * 8;
    for (int r2 = gw; r2 < 16384; r2 += nw) {
        const int r = r2 * 2 + half, which = r >> 14, row = r & 16383;
        const float* src = (which ? p.in(33) : p.in(32)) + ((size_t)layer * 16384 + row) * 1024 + l31 * 32;
        float v[32];
#pragma unroll
        for (int q = 0; q < 8; ++q) { const float4 a = *(const float4*)(src + q * 4); v[q * 4] = a.x; v[q * 4 + 1] = a.y; v[q * 4 + 2] = a.z; v[q * 4 + 3] = a.w; }
        float m = 0.f;
#pragma unroll
        for (int i = 0; i < 32; ++i) m = fmaxf(m, fabsf(v[i]));
#pragma unroll
        for (int o = 16; o >= 1; o >>= 1) m = fmaxf(m, __shfl_xor(m, o));
        const float sc = m > 0.f ? 7.f / m : 1.f;
#pragma unroll
        for (int i = 0; i < 32; ++i) v[i] *= sc;
        unsigned w[6]; fp6x32_pack(v, w);
        unsigned char* dst = p.ws + (which ? O_VT2 : O_UT) + (size_t)row * 768;
        *(uint4*)(dst + l31 * 16) = make_uint4(w[0], w[1], w[2], w[3]); *(uint2*)(dst + 512 + l31 * 8) = make_uint2(w[4], w[5]);
        if (l31 == 0) ((float*)(p.ws + (which ? O_VS : O_US)))[row] = 1.f / sc;
    }
}
#else
__device__ __forceinline__ void convert_peer_tables(const KP& p, int layer, int wg0 = 0, int nwg = 0) {
    if (nwg == 0) nwg = p.G;
    if (p.bid < wg0) return;
    const int lane = p.tid & 63, gw = (p.bid - wg0) * 8 + (p.tid >> 6), nw = nwg * 8;
    for (int r = gw; r < 2 * 16384; r += nw) {
        const int which = r >> 14, row = r & 16383;
        const float* src = (which ? p.in(33) : p.in(32)) + ((size_t)layer * 16384 + row) * 1024;
        float v[16]; row_ld<1>(v, src, lane);
        float m = 0.f;
#pragma unroll
        for (int i = 0; i < 16; ++i) m = fmaxf(m, fabsf(v[i]));
        m = wave_max(m);
        const float sc = m > 0.f ? 256.f / m : 1.f;
#pragma unroll
        for (int i = 0; i < 16; ++i) v[i] *= sc;
        *(uint4*)(p.ws + (which ? O_VT2 : O_UT) + (size_t)row * 1024 + lane * 16) = fp8x16_enc(v);
        if (lane == 0) ((float*)(p.ws + (which ? O_VS : O_US)))[row] = 1.f / sc;
    }
}

#endif

__device__ __forceinline__ void phase_ml_gates(const Params& p_, int j, unsigned char* smem) { const KP p = fresh(p_);
    unsigned char* ws = p.ws; const int G = p.G;
    const bf16_t* HB = (const bf16_t*)(ws + O_HB); const bf16_t* WB = (const bf16_t*)(ws + O_WINGB) + (size_t)j * 128 * 1024;
    const float* bin = p.in(9) + (size_t)j * MPROJ + 4096; float* GT = (float*)(ws + O_GATES);
    for (int t = p.bid; t < NCH; t += G) {
        f32x4 acc[4][2];
        gemm_core(p.tid, mkseg(HB + (size_t)t * 128 * D, D, WB, D, D), mkseg(HB, 0, HB, 0, 0), mkseg(HB, 0, HB, 0, 0), smem, acc);
        ACC_FOREACH({ if (n < 16) { const float4 b4 = *(const float4*)(bin + n); st_f4(GT + (size_t)(t * 128 + m) * 16 + n, v[0] + b4.x, v[1] + b4.y, v[2] + b4.z, v[3] + b4.w); } })
    }
}
__device__ __forceinline__ void phase_ml_inproj(const Params& p_, int j, unsigned char* smem) { const KP p = fresh(p_);
    unsigned char* ws = p.ws; const int G = p.G;
    const bf16_t* HB = (const bf16_t*)(ws + O_HB); const bf16_t* W = (const bf16_t*)(ws + O_WIN) + (size_t)j * 4096 * 1024;
    const float* bin = p.in(9) + (size_t)j * MPROJ;
    bf16_t* PQK = (bf16_t*)(ws + M_PQK); bf16_t* VB = (bf16_t*)(ws + M_VB); bf16_t* OB = (bf16_t*)(ws + M_OB);
    big_gemm(p, smem, HB, W, 4096, true, [&](int row_, int col, const f32x4& v) {
        const size_t row = (size_t)row_;
        const float4 b4 = *(const float4*)(bin + col);
        const float a = v[0] + b4.x, b = v[1] + b4.y, c = v[2] + b4.z, d = v[3] + b4.w;
        if (col < 2048) st_bf4(PQK + row * 2048 + col, a, b, c, d);
        else if (col < 3072) st_bf4(VB + row * D + (col - 2048), a, b, c, d);
        else st_bf4(OB + row * D + (col - 3072), sigmoidf_(a), sigmoidf_(b), sigmoidf_(c), sigmoidf_(d));
    });
    const int lane = p.tid & 63, gw = p.bid * 8 + (p.tid >> 6), nw = G * 8;
    const float* GT = (const float*)(ws + O_GATES);
    for (int u = gw; u < 8 * NCH; u += nw) {
        const int dh = u / NCH, c = u % NCH, d = dh >> 2, h = dh & 3;
        const int p0 = 2 * lane, p1 = 2 * lane + 1;
        const int t0 = c * 128 + (d ? 127 - p0 : p0), t1 = c * 128 + (d ? 127 - p1 : p1);
        const float i0 = GT[(size_t)t0 * 16 + d * 4 + h], i1 = GT[(size_t)t1 * 16 + d * 4 + h];
        const float f0 = GT[(size_t)t0 * 16 + 8 + d * 4 + h], f1 = GT[(size_t)t1 * 16 + 8 + d * 4 + h];
        const float l0 = fminf(f0, 0.f) - log1pf(expf(-fabsf(f0))), l1 = fminf(f1, 0.f) - log1pf(expf(-fabsf(f1)));
        float s = l0 + l1, incl = s;
#pragma unroll
        for (int o = 1; o < 64; o <<= 1) { const float y = __shfl_up(incl, o); if (lane >= o) incl += y; }
        const float b0 = incl - s + l0, b1 = incl;
        const float blast = __shfl(b1, 63);
        const float e0 = i0 - b0, e1 = fmaxf(i0 - b0, i1 - b1);
        float pm = e1;
#pragma unroll
        for (int o = 1; o < 64; o <<= 1) { const float y = __shfl_up(pm, o); if (lane >= o) pm = fmaxf(pm, y); }
        float pmprev = __shfl_up(pm, 1); if (lane == 0) pmprev = -INFINITY;
        const float pm0 = fmaxf(pmprev, e0), pm1 = pm;
        const float w0 = blast - b0 + i0, w1 = blast - b1 + i1;
        const float mloc = wave_max(fmaxf(w0, w1));
        const size_t o0 = (size_t)dh * T + t0, o1 = (size_t)dh * T + t1;
        ((float*)(ws + M_BCUM))[o0] = b0; ((float*)(ws + M_BCUM))[o1] = b1;
        ((float*)(ws + M_AS))[o0] = expf(w0 - mloc); ((float*)(ws + M_AS))[o1] = expf(w1 - mloc);
        ((float*)(ws + M_PMAX))[o0] = pm0; ((float*)(ws + M_PMAX))[o1] = pm1;
        if (lane == 0) { ((float*)(ws + M_MLOC))[u] = mloc; ((float*)(ws + M_BLAST))[u] = blast; }
    }
}
__device__ __forceinline__ void phase_ml_conv(const Params& p_, int j, unsigned char* smem) { const KP p = fresh(p_);
    unsigned char* ws = p.ws; const int G = p.G, tid = p.tid;
    const bf16_t* PQK = (const bf16_t*)(ws + M_PQK); const bf16_t* VB = (const bf16_t*)(ws + M_VB);
    bf16_t* QB = (bf16_t*)(ws + M_QB); bf16_t* KB = (bf16_t*)(ws + M_KB); bf16_t* KAT = (bf16_t*)(ws + M_KAT); bf16_t* VT = (bf16_t*)(ws + M_VT);
    const float* AS = (const float*)(ws + M_AS);
    const float* cw = p.in(10) + (size_t)j * 9 * 2048; const float* cb = p.in(11) + (size_t)j * 2048;
    float* tile = (float*)smem;
    const int tl = tid >> 3, c8 = (tid & 7) * 8;
    for (int it = p.bid; it < (T / 64) * 48; it += G) {
        const int tt = it / 48, kind = (it % 48) / 16, cbk = it % 16;
        const int tok = tt * 64 + tl;
        float o[8];
        if (kind < 2) {
            const int ch = kind * 1024 + cbk * 64 + c8;
            { const float4 b0 = *(const float4*)(cb + ch), b1 = *(const float4*)(cb + ch + 4); o[0] = b0.x; o[1] = b0.y; o[2] = b0.z; o[3] = b0.w; o[4] = b1.x; o[5] = b1.y; o[6] = b1.z; o[7] = b1.w; }
            const bool lat = tok >= CTX; const int s = tok - CTX, r = s >> 6, c = s & 63;
#pragma unroll
            for (int di = -1; di <= 1; ++di)
#pragma unroll
                for (int dj = -1; dj <= 1; ++dj) {
                    int nb = -1;
                    if (lat) { const int rr = r + di, cc = c + dj; if (rr >= 0 && rr < ROWS && cc >= 0 && cc < 64) nb = CTX + rr * 64 + cc; }
                    else if (di == 0) { const int tn = tok + dj; if (tn >= 0 && tn < CTX) nb = tn; }
                    if (nb >= 0) {
                        float x[8]; unpack8(*(const uint4*)(PQK + (size_t)nb * 2048 + ch), x);
                        const float* wp = cw + (size_t)((di + 1) * 3 + (dj + 1)) * 2048 + ch;
                        const float4 w0 = *(const float4*)wp, w1 = *(const float4*)(wp + 4);
                        o[0] += x[0] * w0.x; o[1] += x[1] * w0.y; o[2] += x[2] * w0.z; o[3] += x[3] * w0.w; o[4] += x[4] * w1.x; o[5] += x[5] * w1.y; o[6] += x[6] * w1.z; o[7] += x[7] * w1.w;
                    }
                }
#pragma unroll
            for (int i = 0; i < 8; ++i) o[i] = siluf_(o[i]) * (kind == 0 ? 0.0625f : 1.f);
            *(uint4*)((kind == 0 ? QB : KB) + (size_t)tok * D + cbk * 64 + c8) = pack8(o);
        } else {
            unpack8(*(const uint4*)(VB + (size_t)tok * D + cbk * 64 + c8), o);
        }
        if (kind >= 1) {
#pragma unroll
            for (int i = 0; i < 8; ++i) tile[tl * 65 + c8 + i] = o[i];
            __syncthreads();
            const int chl = tid >> 3, t8 = (tid & 7) * 8, chan = cbk * 64 + chl, h = chan >> 8;
            float f[8];
#pragma unroll
            for (int i = 0; i < 8; ++i) f[i] = tile[(t8 + i) * 65 + chl];
            if (kind == 2) *(uint4*)(VT + (size_t)chan * T + tt * 64 + t8) = pack8(f);
            else {
#pragma unroll
                for (int d = 0; d < 2; ++d) {
                    float g[8]; const float* ap = AS + (size_t)(d * 4 + h) * T + tt * 64 + t8;
#pragma unroll
                    for (int i = 0; i < 8; ++i) g[i] = f[i] * ap[i];
                    *(uint4*)(KAT + ((size_t)d * 1024 + chan) * T + tt * 64 + t8) = pack8(g);
                }
            }
            __syncthreads();
        }
    }
}
__device__ __forceinline__ void phase_ml_kvloc(const Params& p_, unsigned char* smem) { const KP p = fresh(p_);
    unsigned char* ws = p.ws; const int G = p.G;
    const bf16_t* KAT = (const bf16_t*)(ws + M_KAT); const bf16_t* VT = (const bf16_t*)(ws + M_VT); bf16_t* KV = (bf16_t*)(ws + M_KVLOC);
    for (int t = p.bid; t < 8 * NCH * 4; t += G) {
        const int u = t >> 2, mi = (t >> 1) & 1, ni = t & 1, dh = u / NCH, c = u % NCH, h = dh & 3;
        f32x4 acc[4][2];
        gemm_core(p.tid, mkseg(VT + (size_t)(h * 256 + mi * 128) * T + c * 128, T, KAT + (size_t)(dh * 256 + ni * 128) * T + c * 128, T, 128), mkseg(VT, 0, VT, 0, 0), mkseg(VT, 0, VT, 0, 0), smem, acc);
        bf16_t* out = KV + (size_t)u * 65536;
        ACC_FOREACH({ st_bf4(out + (size_t)(mi * 128 + m) * 256 + ni * 128 + n, v[0], v[1], v[2], v[3]); })
    }
    float* NLOC = (float*)(ws + M_NLOC);
    for (int it = p.bid * NT + p.tid; it < 8 * NCH * 256; it += G * NT) {
        const int u = it >> 8, dk = it & 255, dh = u / NCH, c = u % NCH;
        const uint4* kp = (const uint4*)(KAT + (size_t)(dh * 256 + dk) * T + c * 128);
        float sum = 0.f;
#pragma unroll
        for (int x = 0; x < 16; ++x) { float f[8]; unpack8(kp[x], f);
#pragma unroll
            for (int y = 0; y < 8; ++y) sum += f[y]; }
        NLOC[it] = sum;
    }
}
__device__ __forceinline__ int chunk_order(int d, int i) { return d == 0 ? i : (i < NCC ? NCC - 1 - i : NCH - 1 - (i - NCC)); }
__device__ __forceinline__ void phase_ml_scan(const Params& p_, int layer) { const KP p = fresh(p_);
    convert_peer_tables(p, layer);
    unsigned char* ws = p.ws;
    const bf16_t* KV = (const bf16_t*)(ws + M_KVLOC); bf16_t* CIN = (bf16_t*)(ws + M_CIN); const float* NLOC = (const float*)(ws + M_NLOC);
    const float* MLOC = (const float*)(ws + M_MLOC); const float* BLAST = (const float*)(ws + M_BLAST); float* MIN = (float*)(ws + M_MIN); float* NIN = (float*)(ws + M_NIN);
    const int gtid = p.bid * NT + p.tid, gstride = p.G * NT;
    constexpr int SB = 10;
    for (int it = gtid; it < 8 * 16384; it += gstride) {
        const int dh = it >> 14, e = (it & 16383) * 4, d = dh >> 2;
#ifdef CPU_EMU
        const bool hn = (it & ~63) < 2048;
#else
        const bool hn = (__builtin_amdgcn_readfirstlane(it) & ~63) < 2048;
#endif
        const int dh2 = (it >> 8) & 7, dk2 = it & 255, d2 = dh2 >> 2;
        float c0 = 0.f, c1 = 0.f, c2 = 0.f, c3 = 0.f, mst = -1e30f, nst = 0.f, mst2 = -1e30f;
        for (int i0 = 0; i0 < NCH; i0 += SB) {
            uint2 kv[SB]; float ml[SB], bl[SB], nl[SB], ml2[SB], bl2[SB];
#pragma unroll
            for (int q = 0; q < SB; ++q) { const int i = i0 + q < NCH ? i0 + q : NCH - 1, u = dh * NCH + chunk_order(d, i);
                kv[q] = *(const uint2*)(KV + (size_t)u * 65536 + e); ml[q] = MLOC[u]; bl[q] = BLAST[u]; nl[q] = 0.f; ml2[q] = 0.f; bl2[q] = 0.f; }
            if (hn) {
#pragma unroll
                for (int q = 0; q < SB; ++q) { const int i = i0 + q < NCH ? i0 + q : NCH - 1, u = dh2 * NCH + chunk_order(d2, i);
                    nl[q] = NLOC[(size_t)u * 256 + dk2]; ml2[q] = MLOC[u]; bl2[q] = BLAST[u]; }
            }
#pragma unroll
            for (int q = 0; q < SB; ++q) if (i0 + q < NCH) {
                const int u = dh * NCH + chunk_order(d, i0 + q);
                st_bf4(CIN + (size_t)u * 65536 + e, c0, c1, c2, c3);
                if (e == 0) MIN[u] = mst;
                const float mn = fmaxf(bl[q] + mst, ml[q]), gp = fexp(bl[q] + mst - mn), gl = fexp(ml[q] - mn);
                c0 = gp * c0 + gl * bflo(kv[q].x); c1 = gp * c1 + gl * bfhi(kv[q].x); c2 = gp * c2 + gl * bflo(kv[q].y); c3 = gp * c3 + gl * bfhi(kv[q].y);
                mst = mn;
            }
            if (hn) {
#pragma unroll
                for (int q = 0; q < SB; ++q) if (i0 + q < NCH) {
                    const int u = dh2 * NCH + chunk_order(d2, i0 + q);
                    NIN[(size_t)u * 256 + dk2] = nst;
                    const float mn = fmaxf(bl2[q] + mst2, ml2[q]), gp = fexp(bl2[q] + mst2 - mn), gl = fexp(ml2[q] - mn);
                    nst = gp * nst + gl * nl[q]; mst2 = mn;
                }
            }
        }
    }
}
__device__ __forceinline__ void ml_out_unit(const KP& p, int j, unsigned char* smem, const int h, const int c) {
    unsigned char* ws = p.ws; const int tid = p.tid, lane = tid & 63, wid = tid >> 6, wm = wid >> 2, wn = wid & 3;
    const bf16_t* PB = (const bf16_t*)(ws + M_PBUF); const bf16_t* VT = (const bf16_t*)(ws + M_VT); const bf16_t* QF = (const bf16_t*)(ws + M_QF); const bf16_t* QW = (const bf16_t*)(ws + M_QBW);
    const bf16_t* CIN = (const bf16_t*)(ws + M_CIN); const bf16_t* OB = (const bf16_t*)(ws + M_OB); bf16_t* HN = (bf16_t*)(ws + M_VB);
    const float* gw = p.in(12) + (size_t)j * D;
    float* spart = (float*)(smem + 36864);
    {
        f32x4 a0[4][2], a1[4][2];
        gemm_core(p.tid, mkseg(PB + (size_t)(h * NCH + c) * 16384, 128, VT + (size_t)(h * 256) * T + c * 128, T, 128),
                  mkseg(QF + (size_t)c * 128 * D + h * 256, D, CIN + (size_t)((0 * 4 + h) * NCH + c) * 65536, 256, 256),
                  mkseg(QW + (size_t)c * 128 * D + h * 256, D, CIN + (size_t)((1 * 4 + h) * NCH + c) * 65536, 256, 256), smem, a0);
        gemm_core(p.tid, mkseg(PB + (size_t)(h * NCH + c) * 16384, 128, VT + (size_t)(h * 256 + 128) * T + c * 128, T, 128),
                  mkseg(QF + (size_t)c * 128 * D + h * 256, D, CIN + (size_t)((0 * 4 + h) * NCH + c) * 65536 + (size_t)128 * 256, 256, 256),
                  mkseg(QW + (size_t)c * 128 * D + h * 256, D, CIN + (size_t)((1 * 4 + h) * NCH + c) * 65536 + (size_t)128 * 256, 256, 256), smem, a1);
        float mu[4], rs[4];
#pragma unroll
        for (int mt = 0; mt < 4; ++mt) {
            float s = 0.f;
#pragma unroll
            for (int nt = 0; nt < 2; ++nt)
#pragma unroll
                for (int i = 0; i < 4; ++i) s += a0[mt][nt][i] + a1[mt][nt][i];
            s += __shfl_xor(s, 16); s += __shfl_xor(s, 32);
            if ((lane >> 4) == 0) spart[wn * 128 + wm * 64 + mt * 16 + (lane & 15)] = s;
        }
        LDS_BARRIER();
#pragma unroll
        for (int mt = 0; mt < 4; ++mt) { const int m = wm * 64 + mt * 16 + (lane & 15); mu[mt] = ((spart[m] + spart[128 + m]) + (spart[256 + m] + spart[384 + m])) * (1.f / 256.f); }
        LDS_BARRIER();
#pragma unroll
        for (int mt = 0; mt < 4; ++mt) {
            float q = 0.f;
#pragma unroll
            for (int nt = 0; nt < 2; ++nt)
#pragma unroll
                for (int i = 0; i < 4; ++i) { const float d0 = a0[mt][nt][i] - mu[mt], d1 = a1[mt][nt][i] - mu[mt]; q += d0 * d0 + d1 * d1; }
            q += __shfl_xor(q, 16); q += __shfl_xor(q, 32);
            if ((lane >> 4) == 0) spart[wn * 128 + wm * 64 + mt * 16 + (lane & 15)] = q;
        }
        LDS_BARRIER();
#pragma unroll
        for (int mt = 0; mt < 4; ++mt) { const int m = wm * 64 + mt * 16 + (lane & 15); rs[mt] = rsqrtf(((spart[m] + spart[128 + m]) + (spart[256 + m] + spart[384 + m])) * (1.f / 256.f) + 1e-5f); }
#pragma unroll
        for (int mt = 0; mt < 4; ++mt)
#pragma unroll
            for (int nt = 0; nt < 2; ++nt)
#pragma unroll
                for (int t2 = 0; t2 < 2; ++t2) {
                    const int m = wm * 64 + mt * 16 + (lane & 15), n = wn * 32 + nt * 16 + (lane >> 4) * 4, col = h * 256 + t2 * 128 + n;
                    const size_t off = (size_t)(c * 128 + m) * D + col;
                    const uint2 ob = *(const uint2*)(OB + off); const float4 g = *(const float4*)(gw + col);
                    const f32x4 x = t2 ? a1[mt][nt] : a0[mt][nt];
                    st_bf4(HN + off, (x[0] - mu[mt]) * rs[mt] * bflo(ob.x) * g.x, (x[1] - mu[mt]) * rs[mt] * bfhi(ob.x) * g.y,
                           (x[2] - mu[mt]) * rs[mt] * bflo(ob.y) * g.z, (x[3] - mu[mt]) * rs[mt] * bfhi(ob.y) * g.w);
                }
    }
}
__device__ __forceinline__ void phase_ml_scores(const Params& p_, int j, unsigned char* smem) { const KP p = fresh(p_);
    unsigned char* ws = p.ws; const int G = p.G, tid = p.tid, lane = tid & 63;
    const bf16_t* QB = (const bf16_t*)(ws + M_QB); const bf16_t* KB = (const bf16_t*)(ws + M_KB);
    bf16_t* PB = (bf16_t*)(ws + M_PBUF); bf16_t* QF = (bf16_t*)(ws + M_QF); bf16_t* QW = (bf16_t*)(ws + M_QBW);
    const float* BC = (const float*)(ws + M_BCUM); const float* PM = (const float*)(ws + M_PMAX); const float* GT = (const float*)(ws + O_GATES);
    const float* MIN = (const float*)(ws + M_MIN); const float* NIN = (const float*)(ws + M_NIN);
    float* sb = (float*)smem;
    float* sg = sb + 256;
    float* smt = sg + 256;
    float* srow = smt + 256;
    float* sqn = srow + 256;
    float* sdec = sqn + 256;
    float* spart = sdec + 256;
    for (int t = p.bid; t < 4 * NCH; t += G) {
        const int h = t / NCH, c = t % NCH;
        f32x4 acc[4][2];
        gemm_core(p.tid, mkseg(QB + (size_t)c * 128 * D + h * 256, D, KB + (size_t)c * 128 * D + h * 256, D, 256), mkseg(QB, 0, QB, 0, 0), mkseg(QB, 0, QB, 0, 0), smem, acc);
        if (tid < 256) {
            const int d = tid >> 7, tl = tid & 127, tok = c * 128 + tl; const size_t idx = (size_t)(d * 4 + h) * T + tok;
            const float b = BC[idx], mi = MIN[(d * 4 + h) * NCH + c], mt = fmaxf(b + mi, b + PM[idx]);
            sb[tid] = b; sg[tid] = GT[(size_t)tok * 16 + d * 4 + h]; smt[tid] = mt; sdec[tid] = expf(b + mi - mt);
        }
        __syncthreads();
        {
            const int pr = tid >> 1, half = tid & 1, d = pr >> 7, tl = pr & 127;
            const bf16_t* qp = QB + (size_t)(c * 128 + tl) * D + h * 256 + half * 128; const float* np_ = NIN + (size_t)((d * 4 + h) * NCH + c) * 256 + half * 128;
            float s = 0.f;
            for (int x = 0; x < 16; ++x) { float f[8]; unpack8(*(const uint4*)(qp + x * 8), f);
#pragma unroll
                for (int y = 0; y < 8; ++y) s += f[y] * np_[x * 8 + y]; }
            s += __shfl_xor(s, 1);
            if (half == 0) sqn[pr] = s;
        }
        float pf[4][2][4], pb[4][2][4];
        {
            const int wid = tid >> 6, wm = wid >> 2, wn = wid & 3;
#pragma unroll
            for (int mt = 0; mt < 4; ++mt) {
                const int m = wm * 64 + mt * 16 + (lane & 15);
                const float bf_ = sb[m], bb_ = sb[128 + m], mf = smt[m], mb = smt[128 + m];
                float rf = 0.f, rb = 0.f;
#pragma unroll
                for (int nt = 0; nt < 2; ++nt) {
                    const int n = wn * 32 + nt * 16 + (lane >> 4) * 4;
#pragma unroll
                    for (int i = 0; i < 4; ++i) {
                        const int s = n + i; const float sv = acc[mt][nt][i];
                        const float vf = (s <= m) ? sv * fexp(bf_ - sb[s] + sg[s] - mf) : 0.f;
                        const float vb = (s >= m) ? sv * fexp(bb_ - sb[128 + s] + sg[128 + s] - mb) : 0.f;
                        pf[mt][nt][i] = vf; pb[mt][nt][i] = vb; rf += vf; rb += vb;
                    }
                }
                rf += __shfl_xor(rf, 16); rf += __shfl_xor(rf, 32); rb += __shfl_xor(rb, 16); rb += __shfl_xor(rb, 32);
                if ((lane >> 4) == 0) { spart[wn * 256 + m] = rf; spart[wn * 256 + 128 + m] = rb; }
            }
        }
        __syncthreads();
        if (tid < 256) {
            const float den = ((spart[tid] + spart[256 + tid]) + (spart[512 + tid] + spart[768 + tid])) + sdec[tid] * sqn[tid];
            const float r = 1.f / fmaxf(fabsf(den), expf(-smt[tid]));
            srow[tid] = r; sqn[tid] = sdec[tid] * r;
        }
        __syncthreads();
        {
            const int wid = tid >> 6, wm = wid >> 2, wn = wid & 3;
            bf16_t* out = PB + (size_t)(h * NCH + c) * 16384;
#pragma unroll
            for (int mt = 0; mt < 4; ++mt) {
                const int m = wm * 64 + mt * 16 + (lane & 15); const float rf = srow[m], rb = srow[128 + m];
#pragma unroll
                for (int nt = 0; nt < 2; ++nt) {
                    const int n = wn * 32 + nt * 16 + (lane >> 4) * 4;
                    st_bf4(out + m * 128 + n, pf[mt][nt][0] * rf + pb[mt][nt][0] * rb, pf[mt][nt][1] * rf + pb[mt][nt][1] * rb,
                           pf[mt][nt][2] * rf + pb[mt][nt][2] * rb, pf[mt][nt][3] * rf + pb[mt][nt][3] * rb);
                }
            }
            for (int g = tid; g < 4096; g += NT) {
                const int tl = g >> 5, c8 = (g & 31) * 8; const size_t off = (size_t)(c * 128 + tl) * D + h * 256 + c8;
                float f[8], o[8]; unpack8(*(const uint4*)(QB + off), f);
                const float s0 = sqn[tl], s1 = sqn[128 + tl];
#pragma unroll
                for (int i = 0; i < 8; ++i) o[i] = f[i] * s0;
                *(uint4*)(QF + off) = pack8(o);
#pragma unroll
                for (int i = 0; i < 8; ++i) o[i] = f[i] * s1;
                *(uint4*)(QW + off) = pack8(o);
            }
        }
        __syncthreads();
        ml_out_unit(p, j, smem, h, c);
        __syncthreads();
    }
}
__device__ __forceinline__ void phase_ml_headnorm(const Params& p_, int j) { const KP p = fresh(p_);
    unsigned char* ws = p.ws; const int lane = p.tid & 63, gw = p.bid * 8 + (p.tid >> 6), nw = p.G * 8;
    const float* HOUT = (const float*)(ws + M_PQK); const bf16_t* OB = (const bf16_t*)(ws + M_OB); bf16_t* HN = (bf16_t*)(ws + M_VB);
    float g[16]; row_ld(g, p.in(12) + (size_t)j * D, lane);
    for (int tok = gw; tok < T; tok += nw) {
        float v[16], o[16]; row_ld(v, HOUT + (size_t)tok * D, lane); row_ld_bf(o, OB + (size_t)tok * D, lane);
        float s0 = 0.f, s1 = 0.f;
#pragma unroll
        for (int i = 0; i < 8; ++i) { s0 += v[i]; s1 += v[8 + i]; }
#pragma unroll
        for (int m = 16; m >= 1; m >>= 1) { s0 += __shfl_xor(s0, m); s1 += __shfl_xor(s1, m); }
        const float mu0 = s0 * (1.f / 256.f), mu1 = s1 * (1.f / 256.f);
        float q0 = 0.f, q1 = 0.f;
#pragma unroll
        for (int i = 0; i < 8; ++i) { const float a = v[i] - mu0, b = v[8 + i] - mu1; q0 += a * a; q1 += b * b; }
#pragma unroll
        for (int m = 16; m >= 1; m >>= 1) { q0 += __shfl_xor(q0, m); q1 += __shfl_xor(q1, m); }
        const float r0 = rsqrtf(q0 * (1.f / 256.f) + 1e-5f), r1 = rsqrtf(q1 * (1.f / 256.f) + 1e-5f);
#pragma unroll
        for (int i = 0; i < 8; ++i) { v[i] = (v[i] - mu0) * r0 * o[i] * g[i]; v[8 + i] = (v[8 + i] - mu1) * r1 * o[8 + i] * g[8 + i]; }
        row_st_bf(HN + (size_t)tok * D, v, lane);
    }
}
__device__ __forceinline__ void phase_proj_out(const Params& p_, size_t offA, size_t offW, size_t offY, unsigned char* smem) { const KP p = fresh(p_);
    const bf16_t* A = (const bf16_t*)(p.ws + offA); const bf16_t* W = (const bf16_t*)(p.ws + offW); bf16_t* Y = (bf16_t*)(p.ws + offY);
    big_gemm(p, smem, A, W, 1024, true, [&](int row, int col, const f32x4& v) { st_bf4(Y + (size_t)row * D + col, v[0], v[1], v[2], v[3]); });
}
__device__ __forceinline__ void phase_ln_mid(const Params& p_, int layer, size_t offY) { const KP p = fresh(p_);
    const bf16_t* Y = (const bf16_t*)(p.ws + offY);
    unsigned char* ws = p.ws; const int lane = p.tid & 63, gw = p.bid * 8 + (p.tid >> 6), nw = p.G * 8;
    float* XS = (float*)(ws + O_XS); bf16_t* HB = (bf16_t*)(ws + O_HB);
    const float* lg = p.in(6) + (size_t)(layer * 2 + 0) * D; const float* lb = p.in(7) + (size_t)(layer * 2 + 0) * D;
    const int t_begin = (layer == DEPTH - 1) ? CTX : 0;
    float g[16], sh[16], sc[16], gg[16], bb[16]; int cls = -1;
    row_ld(gg, lg, lane); row_ld(bb, lb, lane);
    for (int tok = t_begin + gw; tok < T; tok += nw) {
        const int c_ = tok < CTX ? 1 : 0;
        if (c_ != cls) { cls = c_; row_ld(g, modp(p, layer, tok, 2), lane); row_ld(sh, modp(p, layer, tok, 3), lane); row_ld(sc, modp(p, layer, tok, 4), lane); }
        float x[16], y[16]; row_ld(x, XS + (size_t)tok * D, lane); row_ld_bf(y, Y + (size_t)tok * D, lane);
#pragma unroll
        for (int i = 0; i < 16; ++i) x[i] = DN_ALPHA * x[i] + g[i] * y[i];
        {
            float s = 0.f;
#pragma unroll
            for (int i = 0; i < 16; ++i) s += x[i];
            const float mu = wave_sum(s) * (1.f / 1024.f);
            float q = 0.f;
#pragma unroll
            for (int i = 0; i < 16; ++i) { const float d = x[i] - mu; q += d * d; }
            const float rs = rsqrtf(wave_sum(q) * (1.f / 1024.f) + 1e-5f);
#pragma unroll
            for (int i = 0; i < 16; ++i) x[i] = (x[i] - mu) * rs * gg[i] + bb[i];
        }
        row_st(XS + (size_t)tok * D, x, lane);
#pragma unroll
        for (int i = 0; i < 16; ++i) y[i] = x[i] * (1.f + sc[i]) + sh[i];
        row_st_bf(HB + (size_t)tok * D, y, lane);
    }
}

__device__ __forceinline__ void phase_rw_mix(const Params& p_, int layer) { const KP p = fresh(p_);
    unsigned char* ws = p.ws; const int lane = p.tid & 63, gw = p.bid * 8 + (p.tid >> 6), nw = p.G * 8, j = layer >> 1;
    const float* XS = (const float*)(ws + O_XS); bf16_t* XM = (bf16_t*)(ws + R_XM);
    const float* mu = p.in(14) + (size_t)j * 6 * D;
    float mrow[6][16], sh[16], sc[16]; int cls = -1;
#pragma unroll
    for (int n = 0; n < 6; ++n) row_ld(mrow[n], mu + (size_t)n * D, lane);
    for (int tok = gw; tok < T; tok += nw) {
        float h[16], nbv[16];
        { const int c_ = tok < CTX ? 1 : 0; if (c_ != cls) { cls = c_; row_ld(sh, modp(p, layer, tok, 0), lane); row_ld(sc, modp(p, layer, tok, 1), lane); } }
        row_ld(h, XS + (size_t)tok * D, lane);
#pragma unroll
        for (int i = 0; i < 16; ++i) h[i] = h[i] * (1.f + sc[i]) + sh[i];
        int na, nb;
        if (tok >= CTX) {
            const int s = tok - CTX, r = s >> 6, c = s & 63;
            if (lane < 32) { na = c > 0 ? tok - 1 : -1; nb = r > 0 ? tok - 64 : -1; }
            else { na = c < 63 ? tok + 1 : -1; nb = r < ROWS - 1 ? tok + 64 : -1; }
        } else { na = tok > 0 ? tok - 1 : -1; nb = tok < CTX - 1 ? tok + 1 : -1; }
        {
            float4 a = make_float4(0.f, 0.f, 0.f, 0.f), b = a, c = a, d = a;
            if (na >= 0) { const float* q = XS + (size_t)na * D + lane * 8; a = *(const float4*)q; b = *(const float4*)(q + 4); }
            if (nb >= 0) { const float* q = XS + (size_t)nb * D + 512 + lane * 8; c = *(const float4*)q; d = *(const float4*)(q + 4); }
            nbv[0] = a.x; nbv[1] = a.y; nbv[2] = a.z; nbv[3] = a.w; nbv[4] = b.x; nbv[5] = b.y; nbv[6] = b.z; nbv[7] = b.w;
            nbv[8] = c.x; nbv[9] = c.y; nbv[10] = c.z; nbv[11] = c.w; nbv[12] = d.x; nbv[13] = d.y; nbv[14] = d.z; nbv[15] = d.w;
        }
#pragma unroll
        for (int i = 0; i < 8; ++i) { nbv[i] = na >= 0 ? nbv[i] * (1.f + sc[i]) + sh[i] : 0.f; nbv[8 + i] = nb >= 0 ? nbv[8 + i] * (1.f + sc[8 + i]) + sh[8 + i] : 0.f; }
#pragma unroll
        for (int n = 0; n < 6; ++n) {
            float o[16];
#pragma unroll
            for (int i = 0; i < 16; ++i) o[i] = h[i] + (nbv[i] - h[i]) * mrow[n][i];
            row_st_bf(XM + ((size_t)n * T + tok) * D, o, lane);
        }
    }
}
__device__ __forceinline__ void phase_rw_proj1(const Params& p_, int j, unsigned char* smem) { const KP p = fresh(p_);
    unsigned char* ws = p.ws; const int G = p.G;
    const bf16_t* XM = (const bf16_t*)(ws + R_XM);
    for (int job = 0; job < 3; ++job) {
        bf16_t* O = (bf16_t*)(ws + (job == 0 ? R_RB : job == 1 ? R_KB : R_VB));
        big_gemm_lat(p, smem, XM + (size_t)job * T * D, (const bf16_t*)(ws + O_WRKV) + (size_t)(j * 3 + job) * 1024 * 1024, 1024,
                     [&](int row, int col, const f32x4& v) { st_bf4(O + (size_t)row * D + col, v[0], v[1], v[2], v[3]); });
    }
    for (int job = 0; job < 3; ++job) {
        bf16_t* O = (bf16_t*)(ws + (job == 0 ? R_RB : job == 1 ? R_KB : R_VB));
        ctx_gemm(p, smem, XM + (size_t)job * T * D, (const bf16_t*)(ws + O_WRKV) + (size_t)(j * 3 + job) * 1024 * 1024, 1024, 0,
                 [&](int row, int col, const f32x4& v) { st_bf4(O + (size_t)row * D + col, v[0], v[1], v[2], v[3]); });
    }
    for (int t = p.bid; t < NCH * 4; t += G) {
        int job, n0; const int q = t & 3, m0 = (t >> 2) * 128;
        if (q == 0) { job = 3; n0 = 0; } else if (q == 1) { job = 4; n0 = 0; } else { job = 5; n0 = (q - 2) * 128; }
        const bf16_t* A = XM + ((size_t)job * T + m0) * D;
        const bf16_t* W = job == 3 ? (const bf16_t*)(ws + O_W1C) + (size_t)j * 128 * 1024 : job == 4 ? (const bf16_t*)(ws + O_A1C) + (size_t)j * 128 * 1024 : (const bf16_t*)(ws + O_G1) + (size_t)j * 256 * 1024;
        f32x4 acc[4][2];
        gemm_core(p.tid, mkseg(A, D, W + (size_t)n0 * D, D, D), mkseg(A, 0, W, 0, 0), mkseg(A, 0, W, 0, 0), smem, acc);
        if (job == 3) { bf16_t* O = (bf16_t*)(ws + R_LW1); ACC_FOREACH({ st_bf4(O + (size_t)(m0 + m) * 128 + n, ftanh(v[0]), ftanh(v[1]), ftanh(v[2]), ftanh(v[3])); }) }
        else if (job == 4) { bf16_t* O = (bf16_t*)(ws + R_LA1); ACC_FOREACH({ st_bf4(O + (size_t)(m0 + m) * 128 + n, v[0], v[1], v[2], v[3]); }) }
        else { bf16_t* O = (bf16_t*)(ws + R_LG1);
            ACC_FOREACH({ const int col = n0 + n; if (col < 192) { const bool ok = col < 160; st_bf4(O + (size_t)(m0 + m) * 192 + col, ok ? sigmoidf_(v[0]) : 0.f, ok ? sigmoidf_(v[1]) : 0.f, ok ? sigmoidf_(v[2]) : 0.f, ok ? sigmoidf_(v[3]) : 0.f); } }) }
    }
}
__device__ __forceinline__ void phase_rw_proj2(const Params& p_, int j, unsigned char* smem) { const KP p = fresh(p_);
    unsigned char* ws = p.ws; const int G = p.G;
    for (int t = p.bid; t < NCH * 40; t += G) {
        const int m0 = (t / 40) * 128, q = t % 40, job = q >> 3, n0 = (q & 7) * 128;
        f32x4 acc[4][2];
        if (job < 2) {
            const bf16_t* A = (const bf16_t*)(ws + R_LW1) + (size_t)m0 * 128 + job * 64; const bf16_t* W = (const bf16_t*)(ws + O_W2) + (size_t)(j * 2 + job) * 1024 * 64 + (size_t)n0 * 64;
            gemm_core(p.tid, mkseg(A, 128, W, 64, 64), mkseg(A, 0, W, 0, 0), mkseg(A, 0, W, 0, 0), smem, acc);
            const float* w0 = p.in(16) + (size_t)(j * 2 + job) * D; bf16_t* O = (bf16_t*)(ws + R_WDEC) + (size_t)job * T * D;
            ACC_FOREACH({ const float4 b = *(const float4*)(w0 + n0 + n);
                st_bf4(O + (size_t)(m0 + m) * D + n0 + n, -0.6065306597f * sigmoidf_(b.x + v[0]), -0.6065306597f * sigmoidf_(b.y + v[1]),
                       -0.6065306597f * sigmoidf_(b.z + v[2]), -0.6065306597f * sigmoidf_(b.w + v[3])); })
        } else if (job < 4) {
            const int z = job - 2;
            const bf16_t* A = (const bf16_t*)(ws + R_LA1) + (size_t)m0 * 128 + z * 64; const bf16_t* W = (const bf16_t*)(ws + O_A2) + (size_t)(j * 2 + z) * 1024 * 64 + (size_t)n0 * 64;
            gemm_core(p.tid, mkseg(A, 128, W, 64, 64), mkseg(A, 0, W, 0, 0), mkseg(A, 0, W, 0, 0), smem, acc);
            const float* a0 = p.in(19) + (size_t)(j * 2 + z) * D; bf16_t* O = (bf16_t*)(ws + R_AA) + (size_t)z * T * D;
            ACC_FOREACH({ const float4 b = *(const float4*)(a0 + n0 + n);
                st_bf4(O + (size_t)(m0 + m) * D + n0 + n, sigmoidf_(b.x + v[0]), sigmoidf_(b.y + v[1]), sigmoidf_(b.z + v[2]), sigmoidf_(b.w + v[3])); })
        } else {
            const bf16_t* A = (const bf16_t*)(ws + R_LG1) + (size_t)m0 * 192; const bf16_t* W = (const bf16_t*)(ws + O_G2) + (size_t)j * 1024 * 192 + (size_t)n0 * 192;
            gemm_core(p.tid, mkseg(A, 192, W, 192, 192), mkseg(A, 0, W, 0, 0), mkseg(A, 0, W, 0, 0), smem, acc);
            bf16_t* O = (bf16_t*)(ws + R_GG);
            ACC_FOREACH({ st_bf4(O + (size_t)(m0 + m) * D + n0 + n, v[0], v[1], v[2], v[3]); })
        }
    }
}
__device__ __forceinline__ float row16_sum(float v) {
#ifdef CPU_EMU
    v += __shfl_xor(v, 1); v += __shfl_xor(v, 2); v += __shfl_xor(v, 4); v += __shfl_xor(v, 8); return v;
#else
    v += __int_as_float(__builtin_amdgcn_update_dpp(0, __float_as_int(v), 0xB1, 0xF, 0xF, true));
    v += __int_as_float(__builtin_amdgcn_update_dpp(0, __float_as_int(v), 0x4E, 0xF, 0xF, true));
    v += __int_as_float(__builtin_amdgcn_update_dpp(0, __float_as_int(v), 0x141, 0xF, 0xF, true));
    v += __int_as_float(__builtin_amdgcn_update_dpp(0, __float_as_int(v), 0x140, 0xF, 0xF, true));
    return v;
#endif
}
#ifdef CPU_EMU
#define WAVE_SYNC() emu_wavesync()
#else
#define WAVE_SYNC() __builtin_amdgcn_wave_barrier()
#endif
__device__ __forceinline__ int rc_tok(int d, int ci, int t) {
    if (d == 0) return ci * 64 + t;
    return (ci * 64 < CTX ? CTX - 1 - ci * 64 : T - 1 - (ci * 64 - CTX)) - t;
}
__device__ __forceinline__ f32x4 mma_tile(const bf16_t* A, const bf16_t* B, f32x4 acc, int lane) {
#pragma unroll
    for (int ks = 0; ks < 64; ks += 32) {
        const bf16x8 a = *(const bf16x8*)(A + (lane & 15) * LSTR + ks + (lane >> 4) * 8);
        const bf16x8 b = *(const bf16x8*)(B + (lane & 15) * LSTR + ks + (lane >> 4) * 8);
        acc = mfma16(b, a, acc);
    }
    return acc;
}
__device__ __forceinline__ int swz_off(int row, int c) { return row * LSTR + ((((c >> 3) ^ (row >> 3)) & 7) << 3) + (c & 7); }
template <bool SA, bool SB>
__device__ __forceinline__ f32x4 mma_tile_s(const bf16_t* Am, int a0, const bf16_t* Bm, int b0, f32x4 acc, int lane) {
    const int ra = a0 + (lane & 15), rb = b0 + (lane & 15);
#pragma unroll
    for (int ks = 0; ks < 64; ks += 32) {
        const int c = ks + (lane >> 4) * 8;
        const bf16x8 a = *(const bf16x8*)(Am + (SA ? swz_off(ra, c) : ra * LSTR + c));
        const bf16x8 b = *(const bf16x8*)(Bm + (SB ? swz_off(rb, c) : rb * LSTR + c));
        acc = mfma16(b, a, acc);
    }
    return acc;
}
__device__ __forceinline__ float quad_sum(float v) {
#ifdef CPU_EMU
    v += __shfl_xor(v, 1); v += __shfl_xor(v, 2); return v;
#else
    v += __int_as_float(__builtin_amdgcn_update_dpp(0, __float_as_int(v), 0xB1, 0xF, 0xF, true));
    v += __int_as_float(__builtin_amdgcn_update_dpp(0, __float_as_int(v), 0x4E, 0xF, 0xF, true));
    return v;
#endif
}
__device__ __forceinline__ float oct_sum(float v) {
    v = quad_sum(v);
#ifdef CPU_EMU
    v += __shfl_xor(v, 4); return v;
#else
    v += __int_as_float(__builtin_amdgcn_update_dpp(0, __float_as_int(v), 0x141, 0xF, 0xF, true));
    return v;
#endif
}
constexpr int L_AR = 0, L_BK = 18432, L_VT = 36864, L_BHT = 46080, L_KHT = 55296, L_LAM = 64512, L_AAK = 80896, L_ARB = 90112, L_ARK = 99328,
              L_RHS = 108544, L_XT = 125952, L_GL = 144384, L_BS = 144640;
#define RC_LOAD(U) { const int _u = (U) < 32 * NC64 ? (U) : 32 * NC64 - 1; const int _dh = _u / NC64, _ci = _u % NC64, _d = _dh >> 4, _h = _dh & 15; \
    const size_t _o = (size_t)rc_tok(_d, _ci, st) * D + _h * 64 + sc8; \
    pf_r = *(const uint4*)((const bf16_t*)(ws + R_RB) + _o); pf_k = *(const uint4*)((const bf16_t*)(ws + R_KB) + _o); pf_v = *(const uint4*)((const bf16_t*)(ws + R_VB) + _o); \
    pf_a = *(const uint4*)((const bf16_t*)(ws + R_AA) + (size_t)_d * T * D + _o); pf_lw = *(const uint4*)((const bf16_t*)(ws + R_WDEC) + (size_t)_d * T * D + _o); }
__device__ __forceinline__ void phase_rw_chunk(const Params& p_, int j) { const KP p = fresh(p_);
    unsigned char* ws = p.ws; unsigned char* sm = p.sm; const int tid = p.tid, lane = tid & 63, wid = tid >> 6, G = p.G;
    bf16_t* sAR = (bf16_t*)(sm + L_AR); bf16_t* sBK = (bf16_t*)(sm + L_BK); bf16_t* sVT = (bf16_t*)(sm + L_VT); bf16_t* sBHT = (bf16_t*)(sm + L_BHT); bf16_t* sKHT = (bf16_t*)(sm + L_KHT);
    float* sLAM = (float*)(sm + L_LAM); bf16_t* sAAK = (bf16_t*)(sm + L_AAK); bf16_t* sARB = (bf16_t*)(sm + L_ARB); bf16_t* sARK = (bf16_t*)(sm + L_ARK);
    float* sRHSA = (float*)(sm + L_RHS); float* sRHSB = (float*)(sm + L_BK);   bf16_t* sXT = (bf16_t*)(sm + L_XT); float* sGL = (float*)(sm + L_GL); float* sBS = (float*)(sm + L_BS);
    const int st = tid >> 3, sc8 = (tid & 7) * 8;
    uint4 pf_r, pf_k, pf_v, pf_a, pf_lw;
    RC_LOAD(p.bid)
    for (int u = p.bid; u < 32 * NC64; u += G) {
        const int dh = u / NC64, ci = u % NC64, d = dh >> 4, h = dh & 15;
        float r8[8], kt8[8], v8[8], kk8[8], kka8[8], lw8[8];
        {
            const int col = h * 64 + sc8;
            float k8[8], a8[8];
            unpack8(pf_r, r8); unpack8(pf_k, k8); unpack8(pf_v, v8); unpack8(pf_a, a8);
            unpack8(pf_lw, lw8);
            RC_LOAD(u + G)
            const float* kkw = p.in(24) + (size_t)j * D + col; const float* ka = p.in(25) + (size_t)j * D + col;
            float nrm = 0.f;
#pragma unroll
            for (int i = 0; i < 8; ++i) { kk8[i] = k8[i] * kkw[i]; nrm += kk8[i] * kk8[i]; }
            nrm = oct_sum(nrm);
            const float rn = 1.f / fmaxf(sqrtf(nrm), 1e-12f);
#pragma unroll
            for (int i = 0; i < 8; ++i) { kk8[i] *= rn; kka8[i] = kk8[i] * a8[i]; kt8[i] = k8[i] * (1.f + (a8[i] - 1.f) * ka[i]); }
        }
        float L8[8], Lp8[8], LL8[8];
        {
            const int tl = lane >> 3;
#pragma unroll
            for (int i = 0; i < 8; ++i) {
                float x = lw8[i], y;
                y = __shfl_up(x, 8); if (tl >= 1) x += y;
                y = __shfl_up(x, 16); if (tl >= 2) x += y;
                y = __shfl_up(x, 32); if (tl >= 4) x += y;
                L8[i] = x;
                if (tl == 7) sBS[wid * 64 + sc8 + i] = x;
            }
            LDS_BARRIER();
            if (wid == 0) { float run = 0.f;
#pragma unroll
                for (int w2 = 0; w2 < 8; ++w2) { const float t = sBS[w2 * 64 + lane]; sBS[w2 * 64 + lane] = run; run += t; }
                sBS[512 + lane] = run; }
            LDS_BARRIER();
#pragma unroll
            for (int i = 0; i < 8; ++i) {
                const float off = sBS[wid * 64 + sc8 + i];
                L8[i] += off; LL8[i] = sBS[512 + sc8 + i];
                const float y = __shfl_up(L8[i], 8); Lp8[i] = tl > 0 ? y : off;
            }
        }
        {
            float fa[8], fr[8], fb[8], fk[8];
#pragma unroll
            for (int i = 0; i < 8; ++i) {
                const int ch = sc8 + i; const float L = L8[i], Lp = Lp8[i], LL = LL8[i];
                const float eL = fexp(L), emL = fexp(-L), eLp = fexp(Lp), eLL = fexp(LL - L);
                fa[i] = -kk8[i] * eLp; fr[i] = r8[i] * eL; fb[i] = kka8[i] * emL; fk[i] = kt8[i] * emL;
                const int so = swz_off(ch, st);
                sBHT[so] = f2bf(kka8[i] * eLL); sKHT[so] = f2bf(kt8[i] * eLL); sVT[so] = f2bf(v8[i]);
                if (st == 63) sGL[ch] = fexp(LL);
            }
            { const uint4 pa = pack8(fa); *(uint4*)(sAR + st * LSTR + sc8) = pa; float fb2[8]; unpack8(pa, fb2);
              *(float4*)(sRHSA + st * 68 + sc8) = make_float4(fb2[0], fb2[1], fb2[2], fb2[3]); *(float4*)(sRHSA + st * 68 + sc8 + 4) = make_float4(fb2[4], fb2[5], fb2[6], fb2[7]); }
            *(uint4*)(sAR + (64 + st) * LSTR + sc8) = pack8(fr);
            *(uint4*)(sBK + st * LSTR + sc8) = pack8(fb); *(uint4*)(sBK + (64 + st) * LSTR + sc8) = pack8(fk);
        }
        LDS_BARRIER();
        for (int rep2 = 0; rep2 < REP_S2; ++rep2) {
            const int wm = wid >> 2, wn = wid & 3;
#pragma unroll
            for (int mt = 0; mt < 4; ++mt)
#pragma unroll
                for (int nt = 0; nt < 2; ++nt) {
                    const int m0 = wm * 64 + mt * 16, n0 = wn * 32 + nt * 16;
                    const f32x4 c = mma_tile(sAR + m0 * LSTR, sBK + n0 * LSTR, (f32x4){0.f, 0.f, 0.f, 0.f}, lane);
                    const int t = (m0 & 63) + (lane & 15), i0 = (n0 & 63) + (lane >> 4) * 4;
                    if (m0 < 64 && n0 < 64) {
#pragma unroll
                        for (int i = 0; i < 4; ++i) sLAM[t * 64 + i * 16 + (i0 >> 2)] = (i0 + i < t) ? c[i] : 0.f;
                    } else if (m0 < 64) {
                        st_bf4(sAAK + t * LSTR + i0, i0 < t ? c[0] : 0.f, i0 + 1 < t ? c[1] : 0.f, i0 + 2 < t ? c[2] : 0.f, i0 + 3 < t ? c[3] : 0.f);
                    } else {
                        st_bf4((n0 < 64 ? sARB : sARK) + t * LSTR + i0, i0 <= t ? c[0] : 0.f, i0 + 1 <= t ? c[1] : 0.f, i0 + 2 <= t ? c[2] : 0.f, i0 + 3 <= t ? c[3] : 0.f);
                    }
                }
        }
        LDS_BARRIER();
        {
#pragma unroll
            for (int q = 0; q < 2; ++q) {
                const int idx = wid * 2 + q, mt = idx >> 2, nt = idx & 3;
                const f32x4 c = mma_tile_s<false, true>(sAAK, mt * 16, sVT, nt * 16, (f32x4){0.f, 0.f, 0.f, 0.f}, lane);
                *(float4*)(sRHSB + (mt * 16 + (lane & 15)) * 68 + nt * 16 + (lane >> 4) * 4) = make_float4(c[0], c[1], c[2], c[3]);
            }
        }
        LDS_BARRIER();
        for (int rep4 = 0; rep4 < REP_S4; ++rep4) {
            const int col = tid >> 2, q = tid & 3;
            const float* rb = col < 64 ? sRHSA + col : sRHSB + (col - 64);
            float xs[16];
#pragma unroll
            for (int jj = 0; jj < 16; ++jj) xs[jj] = 0.f;
#pragma unroll
            for (int t = 0; t < 64; ++t) {
                const float rhs = rb[t * 68];
                float part = 0.f;
#pragma unroll
                for (int jj = 0; jj * 4 < t; ++jj) part += sLAM[t * 64 + q * 16 + jj] * xs[jj];
                const float xt = rhs + quad_sum(part);
                xs[t >> 2] = (q == (t & 3)) ? xt : xs[t >> 2];
            }
#pragma unroll
            for (int jj = 0; jj < 16; ++jj) sXT[col * LSTR + jj * 4 + q] = f2bf(xs[jj]);
        }
        LDS_BARRIER();
        for (int rep5 = 0; rep5 < REP_S56; ++rep5) {
            bf16_t* RP = (bf16_t*)(ws + R_RP) + (size_t)u * 4096; bf16_t* Yd = (bf16_t*)(ws + R_XM) + (size_t)d * T * D + h * 64;
#pragma unroll
            for (int mt = 0; mt < 4; ++mt) {
                const int t = mt * 16 + (lane & 15), n = (lane >> 4) * 4;
                if (wid < 4) {
                    const f32x4 c = mma_tile(sARB + mt * 16 * LSTR, sXT + wid * 16 * LSTR, (f32x4){0.f, 0.f, 0.f, 0.f}, lane);
                    const bf16_t* rt = sAR + (64 + t) * LSTR + wid * 16 + n;
                    st_bf4(RP + t * 64 + wid * 16 + n, c[0] + bf2f(rt[0]), c[1] + bf2f(rt[1]), c[2] + bf2f(rt[2]), c[3] + bf2f(rt[3]));
                } else {
                    const int v0 = (wid - 4) * 16;
                    f32x4 c = mma_tile(sARB + mt * 16 * LSTR, sXT + (64 + v0) * LSTR, (f32x4){0.f, 0.f, 0.f, 0.f}, lane);
                    c = mma_tile_s<false, true>(sARK, mt * 16, sVT, v0, c, lane);
                    st_bf4(Yd + (size_t)rc_tok(d, ci, t) * D + v0 + n, c[0], c[1], c[2], c[3]);
                }
            }
        }
        {
            bf16_t* MTo = (bf16_t*)(ws + R_MT) + (size_t)u * 4096; bf16_t* NNo = (bf16_t*)(ws + R_NN) + (size_t)u * 4096;
#pragma unroll
            for (int q = 0; q < 2; ++q) {
                const int idx = wid * 2 + q, mt = idx >> 2, nt = idx & 3;
                const int m = mt * 16 + (lane & 15), n = nt * 16 + (lane >> 4) * 4;
                f32x4 c = mma_tile_s<true, false>(sBHT, mt * 16, sXT, nt * 16, (f32x4){0.f, 0.f, 0.f, 0.f}, lane);
                const float gl = sGL[m];
                st_bf4(MTo + m * 64 + n, c[0] + (m == n ? gl : 0.f), c[1] + (m == n + 1 ? gl : 0.f), c[2] + (m == n + 2 ? gl : 0.f), c[3] + (m == n + 3 ? gl : 0.f));
                f32x4 e = mma_tile_s<false, true>(sXT, 64 + mt * 16, sBHT, nt * 16, (f32x4){0.f, 0.f, 0.f, 0.f}, lane);
                e = mma_tile_s<true, true>(sVT, mt * 16, sKHT, nt * 16, e, lane);
                st_bf4(NNo + m * 64 + n, e[0], e[1], e[2], e[3]);
            }
        }
        LDS_BARRIER();
    }
}
constexpr int C_XB = 0, C_BUF0 = 9216, C_RP = 0, C_MT = 9216, C_NN = 18432, C_BUFSZ = 35840;
#define CH_DECL(P) uint4 P##r0, P##r1, P##m0, P##m1; uint2 P##n0
#define CH_LOAD(P, CI) { const int _ci = (CI); const size_t _u = (size_t)dh * NC64 + (_ci < NC64 ? _ci : NC64 - 1); \
    const bf16_t* _RP = (const bf16_t*)(ws + R_RP) + _u * 4096; const bf16_t* _MT = (const bf16_t*)(ws + R_MT) + _u * 4096; const bf16_t* _NN = (const bf16_t*)(ws + R_NN) + _u * 4096; \
    P##r0 = *(const uint4*)(_RP + lt * 8); P##r1 = *(const uint4*)(_RP + (lt + 256) * 8); P##m0 = *(const uint4*)(_MT + lt * 8); P##m1 = *(const uint4*)(_MT + (lt + 256) * 8); \
    P##n0 = *(const uint2*)(_NN + v0 * 64 + lt * 4); }
#define CH_STORE(P, BUF) { unsigned char* _b = (BUF); const int _row0 = lt >> 3, _c8 = (lt & 7) * 8, _rn = lt >> 4, _c4 = (lt & 15) * 4; \
    *(uint4*)((bf16_t*)(_b + C_RP) + _row0 * LSTR + _c8) = P##r0; *(uint4*)((bf16_t*)(_b + C_RP) + (_row0 + 32) * LSTR + _c8) = P##r1; \
    *(uint4*)((bf16_t*)(_b + C_MT) + _row0 * LSTR + _c8) = P##m0; *(uint4*)((bf16_t*)(_b + C_MT) + (_row0 + 32) * LSTR + _c8) = P##m1; \
    *(float4*)((float*)(_b + C_NN) + _rn * 68 + _c4) = make_float4(bflo(P##n0.x), bfhi(P##n0.x), bflo(P##n0.y), bfhi(P##n0.y)); }
__device__ __forceinline__ void chain_update(const unsigned char* buf, bf16_t* xnew, bf16x8 (&sa)[2], int lane) {
    const bf16_t* MTb = (const bf16_t*)(buf + C_MT); const float* NNb = (const float*)(buf + C_NN);
#pragma unroll
    for (int nt = 0; nt < 4; ++nt) {
        f32x4 acc;
#pragma unroll
        for (int i = 0; i < 4; ++i) acc[i] = NNb[((lane >> 4) * 4 + i) * 68 + nt * 16 + (lane & 15)];
#pragma unroll
        for (int ks = 0; ks < 2; ++ks) acc = mfma16(sa[ks], *(const bf16x8*)(MTb + (nt * 16 + (lane & 15)) * LSTR + ks * 32 + (lane >> 4) * 8), acc);
#pragma unroll
        for (int i = 0; i < 4; ++i) xnew[((lane >> 4) * 4 + i) * LSTR + nt * 16 + (lane & 15)] = f2bf(acc[i]);
    }
    WAVE_SYNC();
#pragma unroll
    for (int ks = 0; ks < 2; ++ks) sa[ks] = *(const bf16x8*)(xnew + (lane & 15) * LSTR + ks * 32 + (lane >> 4) * 8);
    WAVE_SYNC();
}
__device__ __forceinline__ void chain_y(const unsigned char* buf, const bf16_t* xprev, bf16_t* Yc, int d, int ci, int lane) {
    const bf16_t* RPb = (const bf16_t*)(buf + C_RP);
    bf16x8 sp[2];
#pragma unroll
    for (int ks = 0; ks < 2; ++ks) sp[ks] = *(const bf16x8*)(xprev + (lane & 15) * LSTR + ks * 32 + (lane >> 4) * 8);
#pragma unroll
    for (int tt = 0; tt < 4; ++tt) {
        f32x4 acc = {0.f, 0.f, 0.f, 0.f};
#pragma unroll
        for (int ks = 0; ks < 2; ++ks) acc = mfma16(sp[ks], *(const bf16x8*)(RPb + (tt * 16 + (lane & 15)) * LSTR + ks * 32 + (lane >> 4) * 8), acc);
        st_bf4(Yc + (size_t)rc_tok(d, ci, tt * 16 + (lane & 15)) * D, acc[0], acc[1], acc[2], acc[3]);
    }
}
__device__ __forceinline__ void phase_rw_chain(const Params& p_, int layer) { const KP p = fresh(p_);
    unsigned char* ws = p.ws; unsigned char* sm = p.sm; const int tid = p.tid, lane = tid & 63, wid = tid >> 6, G = p.G;
    constexpr int NC4 = (NC64 + 3) & ~3;
    for (int item = p.bid; item < 128; item += G) {
        const int dh = ((item >> 3) >> 2) * 8 + (item & 7), v0 = ((item >> 3) & 3) * 16, d = dh >> 4, h = dh & 15;
        LDS_BARRIER();
        if (wid >= 4) {
            const int lt = tid - 256;
            CH_DECL(A); CH_DECL(B); CH_DECL(C); CH_DECL(E);
            CH_LOAD(A, 0) CH_STORE(A, sm + C_BUF0)
            CH_LOAD(A, 1) CH_LOAD(B, 2) CH_LOAD(C, 3) CH_LOAD(E, 4)
            LDS_BARRIER();
            for (int ci = 0; ci < NC4; ci += 4) {
                CH_STORE(A, sm + C_BUF0 + C_BUFSZ) CH_LOAD(A, ci + 5)
                LDS_BARRIER();
                CH_STORE(B, sm + C_BUF0) CH_LOAD(B, ci + 6)
                LDS_BARRIER();
                CH_STORE(C, sm + C_BUF0 + C_BUFSZ) CH_LOAD(C, ci + 7)
                LDS_BARRIER();
                CH_STORE(E, sm + C_BUF0) CH_LOAD(E, ci + 8)
                LDS_BARRIER();
            }
        } else {
            bf16_t* xbuf = (bf16_t*)(sm + C_XB);
            bf16_t* Yc = (bf16_t*)(ws + R_WDEC) + (size_t)d * T * D + h * 64 + v0 + (lane >> 4) * 4;
            bf16x8 sa[2];
#pragma unroll
            for (int ks = 0; ks < 2; ++ks)
#pragma unroll
                for (int i = 0; i < 8; ++i) sa[ks][i] = 0;
            if (wid == 1) { for (int i = lane; i < 16 * LSTR; i += 64) xbuf[16 * LSTR + i] = 0; }
            LDS_BARRIER();
            for (int ci = 0; ci < NC4; ci += 4) {
#pragma unroll
                for (int q = 0; q < 4; ++q) {
                    if (ci + q < NC64) {
                        if (wid == 0) chain_update(sm + C_BUF0 + (q & 1) * C_BUFSZ, xbuf + (q & 1) * 16 * LSTR, sa, lane);
                        else if (wid == 1) chain_y(sm + C_BUF0 + (q & 1) * C_BUFSZ, xbuf + ((q & 1) ^ 1) * 16 * LSTR, Yc, d, ci + q, lane);
                    }
                    LDS_BARRIER();
                }
            }
        }
    }
    if (G > 128) convert_peer_tables(p, layer, 128, G - 128); else convert_peer_tables(p, layer);
}
__device__ __forceinline__ void phase_rw_finish(const Params& p_, int j) { const KP p = fresh(p_);
    unsigned char* ws = p.ws; const int lane = p.tid & 63, gw = p.bid * 8 + (p.tid >> 6), nw = p.G * 8;
    const bf16_t* YF = (const bf16_t*)(ws + R_XM); const bf16_t* YB = YF + (size_t)T * D;
    float ka[16], rk[16], lg[16], lb[16];
    row_ld(ka, p.in(25) + (size_t)j * D, lane); row_ld(rk, p.in(26) + (size_t)j * D, lane); row_ld(lg, p.in(27) + (size_t)j * D, lane); row_ld(lb, p.in(28) + (size_t)j * D, lane);
#pragma unroll 1
    for (int tok = gw; tok < T; tok += nw) {
        float b0 = 0.f, b1 = 0.f;
        {
            float r[16], k[16], a0[16], a1[16];
            row_ld_bf(r, (const bf16_t*)(ws + R_RB) + (size_t)tok * D, lane); row_ld_bf(k, (const bf16_t*)(ws + R_KB) + (size_t)tok * D, lane);
            row_ld_bf(a0, (const bf16_t*)(ws + R_AA) + (size_t)tok * D, lane); row_ld_bf(a1, (const bf16_t*)(ws + R_AA) + ((size_t)T + tok) * D, lane);
#pragma unroll
            for (int i = 0; i < 16; ++i) { const float kbar = k[i] * (1.f + (0.5f * (a0[i] + a1[i]) - 1.f) * ka[i]); const float t = r[i] * kbar * rk[i]; if (i < 8) b0 += t; else b1 += t; }
#pragma unroll
            for (int m = 4; m >= 1; m >>= 1) { b0 += __shfl_xor(b0, m); b1 += __shfl_xor(b1, m); }
        }
        float y[16];
        {
            float t2[16];
            row_ld_bf(y, YF + (size_t)tok * D, lane); row_ld_bf(t2, YB + (size_t)tok * D, lane);
#pragma unroll
            for (int i = 0; i < 16; ++i) y[i] += t2[i];
            row_ld_bf(t2, (const bf16_t*)(ws + R_WDEC) + (size_t)tok * D, lane);
#pragma unroll
            for (int i = 0; i < 16; ++i) y[i] += t2[i];
            row_ld_bf(t2, (const bf16_t*)(ws + R_WDEC) + ((size_t)T + tok) * D, lane);
#pragma unroll
            for (int i = 0; i < 16; ++i) y[i] += t2[i];
        }
        float s0 = 0.f, s1 = 0.f;
#pragma unroll
        for (int i = 0; i < 8; ++i) { s0 += y[i]; s1 += y[8 + i]; }
#pragma unroll
        for (int m = 4; m >= 1; m >>= 1) { s0 += __shfl_xor(s0, m); s1 += __shfl_xor(s1, m); }
        const float mu0 = s0 * (1.f / 64.f), mu1 = s1 * (1.f / 64.f);
        float q0 = 0.f, q1 = 0.f;
#pragma unroll
        for (int i = 0; i < 8; ++i) { const float a = y[i] - mu0, b = y[8 + i] - mu1; q0 += a * a; q1 += b * b; }
#pragma unroll
        for (int m = 4; m >= 1; m >>= 1) { q0 += __shfl_xor(q0, m); q1 += __shfl_xor(q1, m); }
        const float r0 = rsqrtf(q0 * (1.f / 64.f) + 64e-5f), r1 = rsqrtf(q1 * (1.f / 64.f) + 64e-5f);
        {
#pragma unroll
            for (int i = 0; i < 8; ++i) { y[i] = (y[i] - mu0) * r0 * lg[i] + lb[i]; y[8 + i] = (y[8 + i] - mu1) * r1 * lg[8 + i] + lb[8 + i]; }
        }
        {
            float v[16], g[16];
            row_ld_bf(v, (const bf16_t*)(ws + R_VB) + (size_t)tok * D, lane); row_ld_bf(g, (const bf16_t*)(ws + R_GG) + (size_t)tok * D, lane);
#pragma unroll
            for (int i = 0; i < 8; ++i) { y[i] = (y[i] + b0 * v[i]) * g[i]; y[8 + i] = (y[8 + i] + b1 * v[8 + i]) * g[8 + i]; }
        }
        row_st_bf((bf16_t*)(ws + R_OUTB) + (size_t)tok * D, y, lane);
    }
}

__device__ __forceinline__ unsigned ord_key(float f) { const unsigned u = f2u(f); return u ^ ((u >> 31) ? 0xffffffffu : 0x80000000u); }
__device__ __forceinline__ float ord_val(unsigned k) { const unsigned u = (k >> 31) ? (k ^ 0x80000000u) : ~k; return u2f(u); }
__device__ __forceinline__ void phase_peer_q(const Params& p_, int layer, unsigned char* smem) { const KP p = fresh(p_);
    unsigned char* ws = p.ws; const int G = p.G, c0 = (layer == DEPTH - 1) ? NCC : 0;
    const bf16_t* HB = (const bf16_t*)(ws + O_HB); const bf16_t* W = (const bf16_t*)(ws + O_WQ) + (size_t)layer * 2048 * 1024; bf16_t* QP = (bf16_t*)(ws + P_QP);
    big_gemm(p, smem, HB, W, 2048, c0 == 0, [&](int row, int col, const f32x4& v) { st_bf4(QP + (size_t)row * 2048 + col, v[0], v[1], v[2], v[3]); });
}
#define KCE(x, y) { const unsigned _hi = (x) > (y) ? (x) : (y), _lo = (x) > (y) ? (y) : (x); (x) = _hi; (y) = _lo; }
__device__ __forceinline__ void bitonic_merge16(unsigned* a) {
#pragma unroll
    for (int j = 8; j > 0; j >>= 1)
#pragma unroll
        for (int i = 0; i < 16; ++i) if ((i & j) == 0) KCE(a[i], a[i | j])
}
__device__ __forceinline__ void bitonic_sort16(unsigned* a) {
#pragma unroll
    for (int k = 2; k <= 16; k <<= 1)
#pragma unroll
        for (int j = k >> 1; j > 0; j >>= 1)
#pragma unroll
            for (int i = 0; i < 16; ++i) { const int l = i ^ j; if (l > i) { if ((i & k) == 0 || k == 16) KCE(a[i], a[l]) else KCE(a[l], a[i]) } }
}
__device__ __forceinline__ unsigned quad_xchg(unsigned v, int step) {
#ifdef CPU_EMU
    return __shfl_xor(v, step);
#else
    return step == 1 ? (unsigned)__builtin_amdgcn_update_dpp(0, (int)v, 0xB1, 0xF, 0xF, true) : (unsigned)__builtin_amdgcn_update_dpp(0, (int)v, 0x4E, 0xF, 0xF, true);
#endif
}
__device__ __forceinline__ void phase_peer_scores(const Params& p_, int layer, unsigned char* smem) { const KP p = fresh(p_);
    unsigned char* ws = p.ws; const int G = p.G, tid = p.tid, c0 = (layer == DEPTH - 1) ? NCC : 0;
    const bf16_t* QP = (const bf16_t*)(ws + P_QP); const bf16_t* KEYS = (const bf16_t*)(ws + O_KEYS) + (size_t)layer * 16 * 128 * 128; unsigned* TK = (unsigned*)(ws + P_TK);
    float* sc = (float*)smem;
    for (int t = p.bid; t < (NCH - c0) * 16; t += G) {
        const int m0 = (c0 + t / 16) * 128, hp = t % 16;
        f32x4 acc[4][2];
        gemm_core(p.tid, mkseg(QP + (size_t)m0 * 2048 + hp * 128, 2048, KEYS + (size_t)hp * 128 * 128, 128, 128), mkseg(QP, 0, QP, 0, 0), mkseg(QP, 0, QP, 0, 0), smem, acc);
        ACC_FOREACH({ *(float4*)(sc + m * 132 + n) = make_float4(v[0], v[1], v[2], v[3]); })
        LDS_BARRIER();
        {
            const int row = tid >> 2, q = tid & 3;
            unsigned ka[16], kb[16];
#pragma unroll
            for (int c = 0; c < 16; ++c) {
                ka[c] = (ord_key(sc[row * 132 + 4 * c + q]) & ~127u) | (unsigned)(127 - (4 * c + q));
                kb[c] = (ord_key(sc[row * 132 + 64 + 4 * c + q]) & ~127u) | (unsigned)(127 - (64 + 4 * c + q));
            }
            bitonic_sort16(ka); bitonic_sort16(kb);
#pragma unroll
            for (int i = 0; i < 16; ++i) ka[i] = ka[i] > kb[15 - i] ? ka[i] : kb[15 - i];
            bitonic_merge16(ka);
#pragma unroll
            for (int step = 1; step <= 2; ++step) {
#pragma unroll
                for (int i = 0; i < 16; ++i) kb[i] = quad_xchg(ka[15 - i], step);
#pragma unroll
                for (int i = 0; i < 16; ++i) ka[i] = ka[i] > kb[i] ? ka[i] : kb[i];
                bitonic_merge16(ka);
            }
            if (q == 0) {
                uint4* o = (uint4*)(TK + ((size_t)(m0 + row) * 16 + hp) * 16);
                o[0] = make_uint4(ka[0], ka[1], ka[2], ka[3]); o[1] = make_uint4(ka[4], ka[5], ka[6], ka[7]);
                o[2] = make_uint4(ka[8], ka[9], ka[10], ka[11]); o[3] = make_uint4(ka[12], ka[13], ka[14], ka[15]);
            }
        }
        LDS_BARRIER();
    }
}
__device__ __forceinline__ void phase_peer_select(const Params& p_, int layer) { const KP p = fresh(p_);
    unsigned char* ws = p.ws; const int t_begin = (layer == DEPTH - 1) ? CTX : 0;
    const unsigned* TK = (const unsigned*)(ws + P_TK); int* EIDX = (int*)(ws + P_EIDX); float* GATE = (float*)(ws + P_GATE);
    const int gtid = p.bid * NT + p.tid, gstride = p.G * NT;
    for (int it = gtid; it < (T - t_begin) * 8; it += gstride) {
        const int tok = t_begin + (it >> 3), h = it & 7;
        unsigned k0[16], k1[16];
        { const uint4* q = (const uint4*)(TK + ((size_t)tok * 16 + h * 2) * 16);
#pragma unroll
          for (int i = 0; i < 4; ++i) { const uint4 a = q[i], b = q[4 + i]; k0[4 * i] = a.x; k0[4 * i + 1] = a.y; k0[4 * i + 2] = a.z; k0[4 * i + 3] = a.w; k1[4 * i] = b.x; k1[4 * i + 1] = b.y; k1[4 * i + 2] = b.z; k1[4 * i + 3] = b.w; } }
        unsigned long long top[16];
#pragma unroll
        for (int i = 0; i < 16; ++i) top[i] = 0ull;
#pragma unroll
        for (int i = 0; i < 16; ++i)
#pragma unroll
            for (int jj = 0; jj < 16; ++jj)
                if ((i + 1) * (jj + 1) <= 16) {
                    const float v = ord_val(k0[i] & ~127u) + ord_val(k1[jj] & ~127u);
                    const unsigned e = (127u - (k0[i] & 127u)) * 128u + (127u - (k1[jj] & 127u));
                    unsigned long long x = ((unsigned long long)ord_key(v) << 32) | ((unsigned long long)(255 - (i * 16 + jj)) << 16) | e;
#pragma unroll
                    for (int q = 0; q < 16; ++q) { const unsigned long long hi = top[q] > x ? top[q] : x; x = top[q] > x ? x : top[q]; top[q] = hi; }
                }
        const float vmax = ord_val((unsigned)(top[0] >> 32));
        float ex[16], sum = 0.f;
#pragma unroll
        for (int q = 0; q < 16; ++q) { ex[q] = fexp(ord_val((unsigned)(top[q] >> 32)) - vmax); sum += ex[q]; }
        const float inv = 1.f / sum;
#pragma unroll
        for (int q = 0; q < 16; ++q) { EIDX[(size_t)tok * 128 + h * 16 + q] = (int)(top[q] & 0x3fffu); GATE[(size_t)tok * 128 + h * 16 + q] = ex[q] * inv; }
    }
}
#if PEER_FP6
__device__ __forceinline__ void row2_ld(float* v, const float* p, int l31) {
#pragma unroll
    for (int q = 0; q < 8; ++q) { const float4 a = *(const float4*)(p + l31 * 32 + q * 4); v[q * 4] = a.x; v[q * 4 + 1] = a.y; v[q * 4 + 2] = a.z; v[q * 4 + 3] = a.w; }
}
__device__ __forceinline__ float half_sum_sel(float v, int half) {
#ifdef CPU_EMU
    for (int o = 16; o >= 1; o >>= 1) v += __shfl_xor(v, o);
    return v;
#else
    v += __int_as_float(__builtin_amdgcn_update_dpp(0, __float_as_int(v), 0xB1, 0xF, 0xF, true));
    v += __int_as_float(__builtin_amdgcn_update_dpp(0, __float_as_int(v), 0x4E, 0xF, 0xF, true));
    v += __int_as_float(__builtin_amdgcn_update_dpp(0, __float_as_int(v), 0x141, 0xF, 0xF, true));
    v += __int_as_float(__builtin_amdgcn_update_dpp(0, __float_as_int(v), 0x140, 0xF, 0xF, true));
    v += __int_as_float(__builtin_amdgcn_update_dpp(0, __float_as_int(v), 0x142, 0xA, 0xF, false));
    const float s0 = __int_as_float(__builtin_amdgcn_readlane(__float_as_int(v), 31)), s1 = __int_as_float(__builtin_amdgcn_readlane(__float_as_int(v), 63));
    return half ? s1 : s0;
#endif
}
__device__ __forceinline__ void phase_peer_experts(const Params& p_, int layer) { const KP p = fresh(p_);
    unsigned char* ws = p.ws; const int lane = p.tid & 63, l31 = lane & 31, half = lane >> 5, gw = p.bid * 8 + (p.tid >> 6), nw = p.G * 8;
    const bool last = layer == DEPTH - 1; const int t_begin = last ? CTX : 0;
    float* XS = (float*)(ws + O_XS); const unsigned char* UT = ws + O_UT; const unsigned char* VTb = ws + O_VT2;
    const float* US = (const float*)(ws + O_US); const float* VS = (const float*)(ws + O_VS);
    const int* EIDX = (const int*)(ws + P_EIDX); const float* GATE = (const float*)(ws + P_GATE);
    const float* lg = p.in(6) + (size_t)(layer * 2 + 1) * D; const float* lb = p.in(7) + (size_t)(layer * 2 + 1) * D;
    for (int tok = t_begin + gw; tok < T; tok += nw) {
        float hx[32], acc[32];
        { const uint4* hp = (const uint4*)((const bf16_t*)(ws + O_HB) + (size_t)tok * D + l31 * 32);
#pragma unroll
          for (int q = 0; q < 4; ++q) unpack8(hp[q], hx + 8 * q); }
        const int eA = EIDX[(size_t)tok * 128 + lane], eB = EIDX[(size_t)tok * 128 + 64 + lane];
        const float gA = GATE[(size_t)tok * 128 + lane], gB = GATE[(size_t)tok * 128 + 64 + lane];
        for (int rep_ = 0; rep_ < REP_GATHER; ++rep_) {
#pragma unroll
        for (int i = 0; i < 32; ++i) acc[i] = 0.f;
#pragma unroll
        for (int hh = 0; hh < 2; ++hh) {
            const int ev = hh ? eB : eA; const float gv = hh ? gB : gA;
            for (int e0 = 0; e0 < 64; e0 += 8) {
                uint4 ura[4], vra[4]; uint2 urc[4], vrc[4]; float gt[4], us[4], vs[4];
#pragma unroll
                for (int q = 0; q < 4; ++q) {
#ifdef CPU_EMU
                    const int i0 = __shfl(ev, e0 + 2 * q), i1 = __shfl(ev, e0 + 2 * q + 1); const float g0 = __shfl(gv, e0 + 2 * q), g1 = __shfl(gv, e0 + 2 * q + 1);
#else
                    const int i0 = __builtin_amdgcn_readlane(ev, e0 + 2 * q), i1 = __builtin_amdgcn_readlane(ev, e0 + 2 * q + 1);
                    const float g0 = __int_as_float(__builtin_amdgcn_readlane(__float_as_int(gv), e0 + 2 * q)), g1 = __int_as_float(__builtin_amdgcn_readlane(__float_as_int(gv), e0 + 2 * q + 1));
#endif
                    const int idx = half ? i1 : i0; gt[q] = half ? g1 : g0;
                    const unsigned char* up = UT + (size_t)idx * 768; const unsigned char* vp = VTb + (size_t)idx * 768;
                    ura[q] = *(const uint4*)(up + l31 * 16); urc[q] = *(const uint2*)(up + 512 + l31 * 8); vra[q] = *(const uint4*)(vp + l31 * 16); vrc[q] = *(const uint2*)(vp + 512 + l31 * 8);
                    us[q] = US[idx]; vs[q] = VS[idx];
                }
#pragma unroll
                for (int q = 0; q < 4; ++q) {
                    float f[32];
                    { const unsigned w[6] = {ura[q].x, ura[q].y, ura[q].z, ura[q].w, urc[q].x, urc[q].y}; fp6x32_dec(w, f); }
                    float s = 0.f;
#pragma unroll
                    for (int i = 0; i < 32; ++i) s += f[i] * hx[i];
                    s = half_sum_sel(s, half) * us[q];
                    const float wgt = gt[q] * 0.5f * s * (1.f + erff(s * 0.70710678118f)) * vs[q];
                    { const unsigned w[6] = {vra[q].x, vra[q].y, vra[q].z, vra[q].w, vrc[q].x, vrc[q].y}; fp6x32_dec(w, f); }
#pragma unroll
                    for (int i = 0; i < 32; ++i) acc[i] += wgt * f[i];
                }
            }
        }
        }
        float x[32];
        row2_ld(x, XS + (size_t)tok * D, l31);
        { float g[32]; { const uint4* gp_ = (const uint4*)(ws + O_CROW + ((unsigned)(layer * 4 + (tok < CTX ? 1 : 0)) * 2048u + (unsigned)l31 * 64u));
#pragma unroll
            for (int q = 0; q < 4; ++q) unpack8(gp_[q], g + 8 * q); }
#pragma unroll
          for (int i = 0; i < 32; ++i) { const float a = acc[i] + __shfl_xor(acc[i], 32); x[i] = DN_ALPHA * x[i] + g[i] * a; } }
        {
            float s = 0.f;
#pragma unroll
            for (int i = 0; i < 32; ++i) s += x[i];
            const float mu = wave_sum(s) * (1.f / 2048.f);
            float q = 0.f;
#pragma unroll
            for (int i = 0; i < 32; ++i) { const float dd = x[i] - mu; q += dd * dd; }
            const float rs = rsqrtf(wave_sum(q) * (1.f / 2048.f) + 1e-5f);
            float gg[32], bb[32]; { const uint4* gp_ = (const uint4*)(ws + O_CROW + ((unsigned)(layer * 4 + 2) * 2048u + (unsigned)l31 * 64u)); const uint4* bp_ = (const uint4*)(ws + O_CROW + ((unsigned)(layer * 4 + 3) * 2048u + (unsigned)l31 * 64u));
#pragma unroll
              for (int q = 0; q < 4; ++q) { unpack8(gp_[q], gg + 8 * q); unpack8(bp_[q], bb + 8 * q); } }
#pragma unroll
            for (int i = 0; i < 32; ++i) x[i] = (x[i] - mu) * rs * gg[i] + bb[i];
        }
        float* dstrow = last ? p.out() + (size_t)(tok - CTX) * D : XS + (size_t)tok * D;
        if (half == 0) {
#pragma unroll
            for (int q = 0; q < 8; ++q) *(float4*)(dstrow + l31 * 32 + q * 4) = make_float4(x[q * 4], x[q * 4 + 1], x[q * 4 + 2], x[q * 4 + 3]);
        }
        if (!last && ((layer + 1) & 1) == 0) {
            const int nl = layer + 1, j = nl >> 1;
            float sh[32], sc[32]; row2_ld(sh, modp(p, nl, tok, 0), l31); row2_ld(sc, modp(p, nl, tok, 1), l31);
#pragma unroll
            for (int i = 0; i < 32; ++i) x[i] = x[i] * (1.f + sc[i]) + sh[i];
            if (half == 0) {
                bf16_t* hb = (bf16_t*)(ws + O_HB) + (size_t)tok * D + l31 * 32;
#pragma unroll
                for (int q = 0; q < 4; ++q) *(uint4*)(hb + q * 8) = pack8(x + q * 8);
            }
        }
    }
}
#else
__device__ __forceinline__ void phase_peer_experts(const Params& p_, int layer) { const KP p = fresh(p_);
    unsigned char* ws = p.ws; const int lane = p.tid & 63, gw = p.bid * 8 + (p.tid >> 6), nw = p.G * 8;
    const bool last = layer == DEPTH - 1; const int t_begin = last ? CTX : 0;
    float* XS = (float*)(ws + O_XS); const unsigned char* UT = ws + O_UT; const unsigned char* VTb = ws + O_VT2;
    const float* US = (const float*)(ws + O_US); const float* VS = (const float*)(ws + O_VS);
    const int* EIDX = (const int*)(ws + P_EIDX); const float* GATE = (const float*)(ws + P_GATE);
    const float* lg = p.in(6) + (size_t)(layer * 2 + 1) * D; const float* lb = p.in(7) + (size_t)(layer * 2 + 1) * D;
    for (int tok = t_begin + gw; tok < T; tok += nw) {
        float x[16], hx[16], acc[16];
        row_ld<1>(x, XS + (size_t)tok * D, lane);
        { float sh[16], sc[16]; row_ld<1>(sh, modp(p, layer, tok, 3), lane); row_ld<1>(sc, modp(p, layer, tok, 4), lane);
#pragma unroll
          for (int i = 0; i < 16; ++i) hx[i] = x[i] * (1.f + sc[i]) + sh[i]; }
        for (int rep_ = 0; rep_ < REP_GATHER; ++rep_) {
#pragma unroll
        for (int i = 0; i < 16; ++i) acc[i] = 0.f;
        const int eA = EIDX[(size_t)tok * 128 + lane], eB = EIDX[(size_t)tok * 128 + 64 + lane];
        const float gA = GATE[(size_t)tok * 128 + lane], gB = GATE[(size_t)tok * 128 + 64 + lane];
#pragma unroll
        for (int half = 0; half < 2; ++half) {
            const int ev = half ? eB : eA; const float gv = half ? gB : gA;
            for (int e0 = 0; e0 < 64; e0 += 8) {
                uint4 ua[8], va[8]; float gt[8], us[8], vs[8];
#pragma unroll
                for (int q = 0; q < 8; ++q) {
#ifdef CPU_EMU
                    const int idx = __shfl(ev, e0 + q); gt[q] = __shfl(gv, e0 + q);
#else
                    const int idx = __builtin_amdgcn_readlane(ev, e0 + q); gt[q] = __int_as_float(__builtin_amdgcn_readlane(__float_as_int(gv), e0 + q));
#endif
                    ua[q] = *(const uint4*)(UT + (size_t)idx * 1024 + lane * 16); va[q] = *(const uint4*)(VTb + (size_t)idx * 1024 + lane * 16);
                    us[q] = US[idx]; vs[q] = VS[idx];
                }
#pragma unroll
                for (int q = 0; q < 8; ++q) {
                    float f[16]; fp8x16_dec(ua[q], f);
                    float s = 0.f;
#pragma unroll
                    for (int i = 0; i < 16; ++i) s += f[i] * hx[i];
                    s = wave_sum_fast(s) * us[q];
                    const float wgt = gt[q] * 0.5f * s * (1.f + erff(s * 0.70710678118f)) * vs[q];
                    fp8x16_dec(va[q], f);
#pragma unroll
                    for (int i = 0; i < 16; ++i) acc[i] += wgt * f[i];
                }
            }
        }
        }
        { float g[16]; row_ld<1>(g, modp(p, layer, tok, 5), lane);
#pragma unroll
          for (int i = 0; i < 16; ++i) x[i] = DN_ALPHA * x[i] + g[i] * acc[i]; }
        row_layernorm<1>(x, lg, lb, lane);
        if (last) row_st<1>(p.out() + (size_t)(tok - CTX) * D, x, lane);
        else { row_st<1>(XS + (size_t)tok * D, x, lane); emit_layer_input<1>(p, layer + 1, tok, x, lane); }
    }
}

#endif

#ifdef CPU_EMU
int g_stop_phase = 1000000;
#define PHASE_END() do { grid_sync(kp); if (++phase_no >= g_stop_phase) return; } while (0)
#else
#ifndef STOP_PHASE
#define STOP_PHASE 1000000
#endif
#define PHASE_END() do { grid_sync(kp); if (++phase_no >= STOP_PHASE) return; } while (0)
#endif

__global__ void __launch_bounds__(NT) fwd_megakernel(Params kp) {
    SMEM_DECL;
    const Params& p = kp;
    int phase_no = 0; (void)phase_no;
    (void)gridbar_init((unsigned*)(kp.ws + O_BAR), smem + LDS_BYTES - 16);
    if (PH_MASK & (1u << 0)) { phase_setup(p, smem); if (DUP_MASK & (1u << 0)) { phase_setup(p, smem); } } PHASE_END();
    if (PH_MASK & (1u << 1)) { phase_emit0(p); if (DUP_MASK & (1u << 1)) { phase_emit0(p); } } PHASE_END();
#pragma unroll 1
    for (int layer = 0; layer < DEPTH; ++layer) {
        const int j = layer >> 1;
        size_t Y;
        if ((layer & 1) == 0) {
            phase_ml_gates(p, j, smem); PHASE_END();
            if (PH_MASK & (1u << 2)) { phase_ml_inproj(p, j, smem); if (DUP_MASK & (1u << 2)) { phase_ml_inproj(p, j, smem); } } PHASE_END();
            if (PH_MASK & (1u << 3)) { phase_ml_conv(p, j, smem); if (DUP_MASK & (1u << 3)) { phase_ml_conv(p, j, smem); } } PHASE_END();
            if (PH_MASK & (1u << 4)) { phase_ml_kvloc(p, smem); if (DUP_MASK & (1u << 4)) { phase_ml_kvloc(p, smem); } } PHASE_END();
            if (PH_MASK & (1u << 5)) { phase_ml_scan(p, layer); if (DUP_MASK & (1u << 5)) { phase_ml_scan(p, layer); } } PHASE_END();
            if (PH_MASK & (1u << 6)) { phase_ml_scores(p, j, smem); if (DUP_MASK & (1u << 6)) { phase_ml_scores(p, j, smem); } } PHASE_END();
            if (PH_MASK & (1u << 9)) { phase_proj_out(p, M_VB, O_WOUTM + (size_t)j * 1024 * 1024 * 2, M_KVLOC, smem); if (DUP_MASK & (1u << 9)) { phase_proj_out(p, M_VB, O_WOUTM + (size_t)j * 1024 * 1024 * 2, M_KVLOC, smem); } } PHASE_END();
            Y = M_KVLOC;
        } else {
            if (PH_MASK & (1u << 10)) { phase_rw_mix(p, layer); if (DUP_MASK & (1u << 10)) { phase_rw_mix(p, layer); } } PHASE_END();
            if (PH_MASK & (1u << 11)) { phase_rw_proj1(p, j, smem); if (DUP_MASK & (1u << 11)) { phase_rw_proj1(p, j, smem); } } PHASE_END();
            if (PH_MASK & (1u << 12)) { phase_rw_proj2(p, j, smem); if (DUP_MASK & (1u << 12)) { phase_rw_proj2(p, j, smem); } } PHASE_END();
            if (PH_MASK & (1u << 14)) { phase_rw_chunk(p, j); if (DUP_MASK & (1u << 14)) { phase_rw_chunk(p, j); } } PHASE_END();
            if (PH_MASK & (1u << 13)) { phase_rw_chain(p, layer); if (DUP_MASK & (1u << 13)) { phase_rw_chain(p, layer); } } PHASE_END();
            if (PH_MASK & (1u << 15)) { phase_rw_finish(p, j); if (DUP_MASK & (1u << 15)) { phase_rw_finish(p, j); } } PHASE_END();
            if (PH_MASK & (1u << 16)) { phase_proj_out(p, R_OUTB, O_WOUTR + (size_t)j * 1024 * 1024 * 2, R_XM + (size_t)2 * T * D * 4, smem); if (DUP_MASK & (1u << 16)) { phase_proj_out(p, R_OUTB, O_WOUTR + (size_t)j * 1024 * 1024 * 2, R_XM + (size_t)2 * T * D * 4, smem); } } PHASE_END();
            Y = R_XM + (size_t)2 * T * D * 4;
        }
        if (PH_MASK & (1u << 17)) { phase_ln_mid(p, layer, Y); if (DUP_MASK & (1u << 17)) { phase_ln_mid(p, layer, Y); } } PHASE_END();
        if (PH_MASK & (1u << 18)) { phase_peer_q(p, layer, smem); if (DUP_MASK & (1u << 18)) { phase_peer_q(p, layer, smem); } } PHASE_END();
        if (PH_MASK & (1u << 19)) { phase_peer_scores(p, layer, smem); if (DUP_MASK & (1u << 19)) { phase_peer_scores(p, layer, smem); } } PHASE_END();
        if (PH_MASK & (1u << 20)) { phase_peer_select(p, layer); if (DUP_MASK & (1u << 20)) { phase_peer_select(p, layer); } } PHASE_END();
        if (PH_MASK & (1u << 21)) { phase_peer_experts(p, layer); if (DUP_MASK & (1u << 21)) { phase_peer_experts(p, layer); } } PHASE_END();
    }
}
}

#ifdef CPU_EMU
static void emu_entry(void* a) { fwd_megakernel(*(Params*)a); }
size_t emu_ws_need() { return WS_NEED; }
void emu_set_stop(int n) { g_stop_phase = n; }
size_t emu_off(const char* n) {
#define OFF(x) if (!strcmp(n, #x)) return x;
    OFF(O_MOD) OFF(O_XS) OFF(O_HB) OFF(O_GATES) OFF(O_WIN) OFF(M_PQK) OFF(M_VB) OFF(M_OB) OFF(M_QB) OFF(M_KB) OFF(M_KAT) OFF(M_VT) OFF(M_BCUM) OFF(M_AS) OFF(M_PMAX)
    OFF(M_KVLOC) OFF(M_CIN) OFF(M_PBUF) OFF(M_QF) OFF(M_QBW) OFF(M_NIN) OFF(M_MIN) OFF(R_XM) OFF(R_RB) OFF(R_KB) OFF(R_VB) OFF(R_WDEC) OFF(R_AA) OFF(R_GG) OFF(R_OUTB)
    OFF(P_QP) OFF(P_TK) OFF(P_EIDX) OFF(P_GATE) OFF(R_LW1) OFF(R_LA1) OFF(R_LG1)
    return (size_t)-1;
}
#endif

extern "C" void kernel_launch(void* const* d_in, const int* in_sizes, int n_in, void* d_out, int out_size, void* d_ws, size_t ws_size, hipStream_t stream) {
    Params p{};
    for (int i = 0; i < 34; ++i) p.in[i] = (const float*)d_in[i];
    p.out = (float*)d_out; p.ws = (unsigned char*)d_ws;
#ifdef CPU_EMU
    int grid = getenv("EMU_GRID") ? atoi(getenv("EMU_GRID")) : 4;
    emu_launch(emu_entry, &p, grid, NT, LDS_BYTES);
#else
    static int grid_blocks = 0;
    if (!grid_blocks) {
        if (n_in != 34 || ws_size < WS_NEED) { fprintf(stderr, "kernel_launch: unexpected inputs (n_in %d, ws %zu, need %zu)\n", n_in, ws_size, (size_t)WS_NEED); grid_blocks = -1; return; }
        int dev = 0, cus = 0, per_cu = 0;
        hipGetDevice(&dev);
        hipDeviceGetAttribute(&cus, hipDeviceAttributeMultiprocessorCount, dev);
        hipFuncSetAttribute((const void*)fwd_megakernel, hipFuncAttributeMaxDynamicSharedMemorySize, LDS_BYTES);
        hipOccupancyMaxActiveBlocksPerMultiprocessor(&per_cu, (const void*)fwd_megakernel, NT, LDS_BYTES);
        if (per_cu < 1) { fprintf(stderr, "kernel_launch: occupancy query says %d blocks per CU\n", per_cu); grid_blocks = -1; return; }
        grid_blocks = cus;
    }
    if (grid_blocks < 0) return;
    hipMemsetAsync((char*)d_ws + O_BAR, 0, 16384, stream);
    void* args[] = {&p};
    hipError_t e = hipLaunchCooperativeKernel((const void*)fwd_megakernel, dim3(grid_blocks), dim3(NT), args, LDS_BYTES, stream);
    if (e != hipSuccess) fprintf(stderr, "cooperative launch failed: %s (grid %d)\n", hipGetErrorString(e), grid_blocks);
#endif
}
```
